# Optimizing an MI355X kernel written in HIP

```python
import math
import jax, jax.numpy as jnp
from jax import lax
import numpy as np

D_MODEL = 1024
BATCH = 8
SEQ = 2048
DEPTH = 2
DEC_BATCH = 128
DEC_SEQ = 1
PAST_LEN = 16384
PAGE_SIZE = 128

D_MIX = D_MODEL
N_MIXERS = 4
GROUP_W = D_MIX // N_MIXERS
HEADS_PER_MIXER = 4
HEAD_DIM = GROUP_W // HEADS_PER_MIXER
IN_WIDTH = 8 * GROUP_W
CONV_A_WIDTH = 31
CONV_D_WIDTH = 3
POOL_WINDOWS = (2, 4, 8, 16)
POOL_BUF = max(POOL_WINDOWS) - 1
CHUNK = 128
D_FF = -(-8 * D_MODEL // (3 * 256)) * 256
N_MOD = 6
RMS_EPS = 1e-6
LN_EPS = 1e-5

kernel_name = 'hymba_conv_pool_gmlp_shortconv_decoder'


def rmsnorm(x, g):
    xf = x.astype(jnp.float32)
    y = xf * lax.rsqrt(jnp.mean(xf * xf, axis=-1, keepdims=True) + RMS_EPS)
    return (y * g.astype(jnp.float32)).astype(x.dtype)


def layernorm(x, g, b):
    xf = x.astype(jnp.float32)
    mu = jnp.mean(xf, axis=-1, keepdims=True)
    var = jnp.mean(jnp.square(xf - mu), axis=-1, keepdims=True)
    y = (xf - mu) * lax.rsqrt(var + LN_EPS)
    return (y * g.astype(jnp.float32) + b.astype(jnp.float32)).astype(x.dtype)


def causal_depthwise(z_ext, w):
    c = z_ext.shape[-1]
    return lax.conv_general_dilated(z_ext, w[:, None, :].astype(z_ext.dtype), (1,), 'VALID',
                                    dimension_numbers=('NWC', 'WIO', 'NWC'),
                                    feature_group_count=c)


def multiscale_pool(z_ext, n_prev, w_lin, scale):
    bsz, length, c = z_ext.shape
    t_new = length - n_prev
    gc = c // len(POOL_WINDOWS)
    zf = z_ext.astype(jnp.float32)
    csum = jnp.concatenate([jnp.zeros((bsz, 1, c), jnp.float32), jnp.cumsum(zf, axis=1)], axis=1)
    j = np.arange(n_prev, length)
    outs = []
    for g, w in enumerate(POOL_WINDOWS):
        s_g = csum[..., g * gc:(g + 1) * gc]
        start = np.maximum(j + 1 - w, 0)
        cnt = jnp.asarray((j + 1 - start).astype(np.float32))
        mean = (jnp.take(s_g, j + 1, axis=1) - jnp.take(s_g, start, axis=1)) / cnt[None, :, None]
        outs.append(mean - zf[:, n_prev:, g * gc:(g + 1) * gc])
    d = jnp.stack(outs, axis=2).astype(z_ext.dtype)
    y = jnp.einsum('btgc,gcd->btgd', d, w_lin).reshape(bsz, t_new, c)
    return y * scale


def spatial_gating(v, w_s, b_s):
    bsz, t, c = v.shape
    nc = -(-t // CHUNK)
    vp = jnp.pad(v, ((0, 0), (0, nc * CHUNK - t), (0, 0)))
    vp = vp.reshape(bsz, nc, CHUNK, HEADS_PER_MIXER, c // HEADS_PER_MIXER)
    mask = np.tril(np.ones((CHUNK, CHUNK), dtype=bool))
    wm = jnp.where(mask[None], w_s, jnp.zeros_like(w_s))
    out = jnp.einsum('hij,bnjhc->bnihc', wm, vp) + b_s.T[None, None, :, :, None]
    return out.reshape(bsz, nc * CHUNK, c)[:, :t]


def token_mixer(h, buf_a, buf_b, buf_d, p):
    proj = h @ p['w_in']
    a_val, a_gate, b_in, c_u, c_v, d_b, d_c, d_h = jnp.split(proj, 8, axis=-1)
    za = a_val * jax.nn.sigmoid(a_gate)
    za_ext = jnp.concatenate([buf_a, za], axis=1)
    ya = causal_depthwise(za_ext, p['conv_a_w']) + p['conv_a_b']
    ya = jax.nn.silu(layernorm(ya, p['ln_a_g'], p['ln_a_b']))
    zb_ext = jnp.concatenate([buf_b, b_in], axis=1)
    yb = multiscale_pool(zb_ext, buf_b.shape[1], p['pool_w'], p['pool_scale'])
    vn = layernorm(c_v, p['ln_c_g'], p['ln_c_b'])
    yc = c_u * spatial_gating(vn, p['sgu_w'], p['sgu_b'])
    zd_ext = jnp.concatenate([buf_d, d_c * d_h], axis=1)
    yd = d_b * causal_depthwise(zd_ext, p['conv_d_w'])
    out = jnp.concatenate([ya, yb, yc, yd], axis=-1) @ p['w_out']
    return (out, za_ext[:, -(CONV_A_WIDTH - 1):], zb_ext[:, -POOL_BUF:],
            zd_ext[:, -(CONV_D_WIDTH - 1):], vn)


def decoder_layer(x, c, buf_a, buf_b, buf_d, p):
    mod = (jax.nn.silu(c) @ p['w_ada'] + p['b_ada'])[:, None, :]
    sh1, sc1, gt1, sh2, sc2, gt2 = jnp.split(mod, N_MOD, axis=-1)
    h = rmsnorm(x, p['g_pre_mix']) * (1 + sc1) + sh1
    m, na, nb, nd, vn = token_mixer(h, buf_a, buf_b, buf_d, p)
    x = x + gt1 * rmsnorm(m, p['g_post_mix'])
    h = rmsnorm(x, p['g_pre_ffn']) * (1 + sc2) + sh2
    f = (jax.nn.silu(h @ p['w_gate']) * (h @ p['w_up'])) @ p['w_down']
    x = x + gt2 * rmsnorm(f, p['g_post_ffn'])
    return x, na, nb, nd, vn


def setup_inputs(seed: int = 0) -> dict:
    key = jax.random.key(seed)
    ks = jax.random.split(key, 32)
    nrm = jax.random.normal
    f32 = jnp.float32
    L, D, G = DEPTH, D_MODEL, GROUP_W
    def gain(k, shape):
        return 1.0 + 0.05 * nrm(k, shape, f32)
    return {
        'x_prompt': nrm(ks[0], (BATCH, SEQ, D), f32),
        'x_sample': nrm(ks[1], (DEC_BATCH, DEC_SEQ, D), f32),
        'c_prompt': nrm(ks[2], (BATCH, D), f32),
        'c_sample': nrm(ks[3], (DEC_BATCH, D), f32),
        'state_conv_a': 0.5 * nrm(ks[4], (L, DEC_BATCH, CONV_A_WIDTH - 1, G), f32),
        'state_pool_b': nrm(ks[5], (L, DEC_BATCH, POOL_BUF, G), f32),
        'state_conv_d': 0.5 * nrm(ks[6], (L, DEC_BATCH, CONV_D_WIDTH - 1, G), f32),
        'w_ada': nrm(ks[7], (L, D, N_MOD * D), f32) * D ** -0.5,
        'b_ada': 0.01 * nrm(ks[8], (L, N_MOD * D), f32),
        'g_pre_mix': gain(ks[9], (L, D)),
        'g_post_mix': gain(ks[10], (L, D)),
        'w_in': nrm(ks[11], (L, D, IN_WIDTH), f32) * D ** -0.5,
        'conv_a_w': nrm(ks[12], (L, CONV_A_WIDTH, G), f32) * CONV_A_WIDTH ** -0.5,
        'conv_a_b': 0.02 * nrm(ks[13], (L, G), f32),
        'ln_a_g': gain(ks[14], (L, G)),
        'ln_a_b': 0.02 * nrm(ks[15], (L, G), f32),
        'pool_w': nrm(ks[16], (L, len(POOL_WINDOWS), G // len(POOL_WINDOWS), G // len(POOL_WINDOWS)), f32) * (G // len(POOL_WINDOWS)) ** -0.5,
        'pool_scale': gain(ks[17], (L, G)),
        'ln_c_g': gain(ks[18], (L, G)),
        'ln_c_b': 0.02 * nrm(ks[19], (L, G), f32),
        'sgu_w': nrm(ks[20], (L, HEADS_PER_MIXER, CHUNK, CHUNK), f32) * CHUNK ** -0.5,
        'sgu_b': 1.0 + 0.1 * nrm(ks[21], (L, HEADS_PER_MIXER, CHUNK), f32),
        'conv_d_w': nrm(ks[22], (L, CONV_D_WIDTH, G), f32) * CONV_D_WIDTH ** -0.5,
        'w_out': nrm(ks[23], (L, D_MIX, D), f32) * D_MIX ** -0.5,
        'g_pre_ffn': gain(ks[24], (L, D)),
        'g_post_ffn': gain(ks[25], (L, D)),
        'w_gate': nrm(ks[26], (L, D, D_FF), f32) * D ** -0.5,
        'w_up': nrm(ks[27], (L, D, D_FF), f32) * D ** -0.5,
        'w_down': nrm(ks[28], (L, D_FF, D), f32) * D_FF ** -0.5,
    }


def reference(x_prompt, x_sample, c_prompt, c_sample, state_conv_a, state_pool_b, state_conv_d,
              w_ada, b_ada, g_pre_mix, g_post_mix, w_in, conv_a_w, conv_a_b, ln_a_g, ln_a_b,
              pool_w, pool_scale, ln_c_g, ln_c_b, sgu_w, sgu_b, conv_d_w, w_out,
              g_pre_ffn, g_post_ffn, w_gate, w_up, w_down):
    bp, dt = x_prompt.shape[0], x_prompt.dtype
    buf_a_p = jnp.zeros((bp, CONV_A_WIDTH - 1, GROUP_W), dt)
    buf_b_p = jnp.zeros((bp, 0, GROUP_W), dt)
    buf_d_p = jnp.zeros((bp, CONV_D_WIDTH - 1, GROUP_W), dt)
    xp, xs = x_prompt, x_sample
    na_p, nb_p, nd_p, na_s, nb_s, nd_s, nv_s = [], [], [], [], [], [], []
    for l in range(DEPTH):
        p = {'w_ada': w_ada[l], 'b_ada': b_ada[l], 'g_pre_mix': g_pre_mix[l], 'g_post_mix': g_post_mix[l],
             'w_in': w_in[l], 'conv_a_w': conv_a_w[l], 'conv_a_b': conv_a_b[l], 'ln_a_g': ln_a_g[l],
             'ln_a_b': ln_a_b[l], 'pool_w': pool_w[l], 'pool_scale': pool_scale[l], 'ln_c_g': ln_c_g[l],
             'ln_c_b': ln_c_b[l], 'sgu_w': sgu_w[l], 'sgu_b': sgu_b[l], 'conv_d_w': conv_d_w[l],
             'w_out': w_out[l], 'g_pre_ffn': g_pre_ffn[l], 'g_post_ffn': g_post_ffn[l],
             'w_gate': w_gate[l], 'w_up': w_up[l], 'w_down': w_down[l]}
        xp, a_p, b_p, d_p, _ = decoder_layer(xp, c_prompt, buf_a_p, buf_b_p, buf_d_p, p)
        xs, a_s, b_s, d_s, v_s = decoder_layer(xs, c_sample, state_conv_a[l], state_pool_b[l],
                                               state_conv_d[l], p)
        na_p.append(a_p); nb_p.append(b_p); nd_p.append(d_p)
        na_s.append(a_s); nb_s.append(b_s); nd_s.append(d_s); nv_s.append(v_s)
    return (xp, xs,
            jnp.stack(na_p), jnp.stack(nb_p), jnp.stack(nd_p),
            jnp.stack(na_s), jnp.stack(nb_s), jnp.stack(nd_s), jnp.stack(nv_s))
```

```cpp
#include <hip/hip_runtime.h>
#include <hip/hip_cooperative_groups.h>
#include <cstdio>
#include <cstdint>
namespace cg = cooperative_groups;
namespace pg8 {
#define PG8_LAS __attribute__((address_space(3)))
typedef unsigned short bf16_t;
typedef short bf16x8 __attribute__((ext_vector_type(8)));
typedef float f32x4 __attribute__((ext_vector_type(4)));
typedef unsigned u32x4 __attribute__((ext_vector_type(4)));
constexpr int BM = 256, BK = 64, HALF = 128, HTB = HALF * BK * 2  , STAGE_BYTES = 8 * HTB, NXCD = 8, WGM = 8;

__host__ __device__ __forceinline__ int lds_byte(int r, int c) { const int st = (r >> 4) * 2 + (c >> 5), rr = r & 15, cc = c & 31, ob = rr * 64 + cc * 2; return st * 1024 + (ob ^ (((ob >> 9) & 1) << 5)); }
__host__ __device__ __forceinline__ void stage_rc(int b, int& R, int& C) { const int st = b / 1024, sb = b % 1024, swz = sb ^ (((sb >> 9) & 1) << 5); R = (st >> 1) * 16 + swz / 64; C = (st & 1) * 32 + (swz % 64) / 2; }
__host__ __device__ __forceinline__ int perm32(int rho) { const int n = rho >> 4, i = rho & 15; return 8 * (i >> 2) + 4 * n + (i & 3); }

struct Unit { int pm, pn; };
struct Gemm { const bf16_t* A; const bf16_t* Bt; int M, N, K; };

struct StaticOrder {
    int nM, nN, nwg, G, c;
    __host__ __device__ void init(int M, int N, int G_, int c_) { nM = M / BM; nN = N / BM; nwg = nM * nN; G = G_; c = c_; }
    __host__ __device__ bool next(int i, Unit& u) const {
        const long L = (long)i * G + c; if (L >= nwg) return false;
        int wgid = (int)L; { const int q = nwg / NXCD, r = nwg % NXCD, xcd = wgid % NXCD, off = wgid / NXCD; wgid = (xcd < r ? xcd * (q + 1) : r * (q + 1) + (xcd - r) * q) + off; }
        const int nig = WGM * nN, gid = wgid / nig, fm = gid * WGM, gsz = (nM - fm) < WGM ? (nM - fm) : WGM;
        u.pm = fm + ((wgid % nig) % gsz); u.pn = (wgid % nig) / gsz; return true;
    }
    __device__ __forceinline__ void a_ready(const Unit&) const {}
    __device__ __forceinline__ void done(const Unit&) const {}
};
__device__ __forceinline__ unsigned cvt_pk_bf16(float lo, float hi) { unsigned r; asm volatile("v_cvt_pk_bf16_f32 %0, %1, %2" : "=v"(r) : "v"(lo), "v"(hi)); return r; }
template <class Epi, class Sched, bool ALIGN_EPI = false, bool SP2 = false>
__device__ __forceinline__ void gemm_phase(PG8_LAS unsigned char* lds, const Gemm g, const Sched& S, const Epi& E) {
    int tid_ = threadIdx.x; asm volatile("" : "+v"(tid_)); const int tid = tid_, wid = __builtin_amdgcn_readfirstlane(tid >> 6), lane = tid & 63, wr = wid >> 2, wc = wid & 3, fr = lane & 15, fq = lane >> 4;
    const int K = g.K, nt = K / BK;
    unsigned voffA[2], voffB[2];
#pragma unroll
    for (int i = 0; i < 2; ++i) { int R, C; stage_rc(tid * 16 + i * 8192, R, C); const int Rb = Epi::PERM ? ((R & ~31) + perm32(R & 31)) : R;
        voffA[i] = (unsigned)(R * K + C) * 2u; voffB[i] = (unsigned)(Rb * K + C) * 2u; }
    const size_t kstep = (size_t)(BK * 2);
    const size_t hstep = (size_t)HALF * K * 2;
    const size_t tstep = 2 * hstep;
    const unsigned ldsw = (unsigned)wid * 1024u;
    const int aoff = lds_byte(wr * 64 + fr, fq * 8), boff = lds_byte(wc * 32 + fr, fq * 8);
#define PG8_SA(b, h) (((b) * 2 + (h)) * HTB)
#define PG8_SB(b, h) ((4 + (b) * 2 + (h)) * HTB)
#define PG8_STAGE(bufoff, gbase, voff) do { _Pragma("unroll") for (int _i = 0; _i < 2; ++_i) \
        __builtin_amdgcn_global_load_lds((const unsigned*)((const char*)(gbase) + (voff)[_i]), (PG8_LAS unsigned*)(lds + (bufoff) + ldsw + _i * 8192), 16, 0, 0); } while (0)
#define PG8_LDA(dst, b, h) do { _Pragma("unroll") for (int m = 0; m < 4; ++m) _Pragma("unroll") for (int k = 0; k < 2; ++k) dst[m][k] = *(const PG8_LAS bf16x8*)(lds + PG8_SA(b, h) + aoff + m * 2048 + k * 1024); } while (0)
#define PG8_LDB(dst, b, h) do { _Pragma("unroll") for (int n = 0; n < 2; ++n) _Pragma("unroll") for (int k = 0; k < 2; ++k) dst[n][k] = *(const PG8_LAS bf16x8*)(lds + PG8_SB(b, h) + boff + n * 2048 + k * 1024); } while (0)
#define PG8_MMA(ai, bj, At, Bt) do { __builtin_amdgcn_s_setprio(1); _Pragma("unroll") for (int m = 0; m < 4; ++m) _Pragma("unroll") for (int n = 0; n < 2; ++n) _Pragma("unroll") for (int k = 0; k < 2; ++k) \
        acc[ai][bj][m][n] = __builtin_amdgcn_mfma_f32_16x16x32_bf16(Bt[n][k], At[m][k], acc[ai][bj][m][n], 0, 0, 0); __builtin_amdgcn_s_setprio(0); } while (0)
#define PG8_WAIT_V(n) asm volatile("s_waitcnt vmcnt(" #n ")" ::: "memory")
#define PG8_WAIT_L(n) asm volatile("s_waitcnt lgkmcnt(" #n ")" ::: "memory")
#define PG8_BAR __builtin_amdgcn_s_barrier()
#define PG8_SCHED __builtin_amdgcn_sched_barrier(0)
    Unit cur, nxt; int ui = 0;
    if (!S.next(0, cur)) return;
    f32x4 acc[2][2][4][2];
#pragma unroll
    for (int a = 0; a < 2; ++a)
#pragma unroll
        for (int b = 0; b < 2; ++b)
#pragma unroll
            for (int m = 0; m < 4; ++m)
#pragma unroll
                for (int n = 0; n < 2; ++n) acc[a][b][m][n] = (f32x4){0.f, 0.f, 0.f, 0.f};
    bf16x8 At[4][2], B0[2][2], B1[2][2];
    const char* cA = (const char*)g.A + (size_t)cur.pm * tstep; const char* cB = (const char*)g.Bt + (size_t)cur.pn * tstep;
    S.a_ready(cur);
    if constexpr (SP2) {
        PG8_STAGE(PG8_SB(0, 0), cB, voffB); PG8_STAGE(PG8_SB(0, 1), cB + hstep, voffB); PG8_STAGE(PG8_SA(0, 0), cA, voffA); PG8_STAGE(PG8_SA(0, 1), cA + hstep, voffA);
        if (wr == 1) PG8_BAR;
        PG8_WAIT_V(2); PG8_BAR;
        PG8_STAGE(PG8_SB(1, 0), cB + kstep, voffB); PG8_STAGE(PG8_SA(1, 0), cA + kstep, voffA); PG8_STAGE(PG8_SB(1, 1), cB + hstep + kstep, voffB);
        PG8_WAIT_V(6); PG8_BAR;
    } else {
        PG8_STAGE(PG8_SB(0, 0), cB, voffB); PG8_STAGE(PG8_SA(0, 0), cA, voffA); PG8_STAGE(PG8_SB(0, 1), cB + hstep, voffB); PG8_STAGE(PG8_SA(0, 1), cA + hstep, voffA);
        if (wr == 1) PG8_BAR;
        PG8_WAIT_V(4); PG8_BAR;
        PG8_STAGE(PG8_SB(1, 0), cB + kstep, voffB); PG8_STAGE(PG8_SA(1, 0), cA + kstep, voffA); PG8_STAGE(PG8_SB(1, 1), cB + hstep + kstep, voffB);
        PG8_WAIT_V(6); PG8_BAR;
    }
    for (;;) {
        const bool has_next = S.next(ui + 1, nxt);
        const char* nA = has_next ? (const char*)g.A + (size_t)nxt.pm * tstep : cA; const char* nB = has_next ? (const char*)g.Bt + (size_t)nxt.pn * tstep : cB;
        for (int t = 0; t < nt; t += 2) {
            const bool last = (t == nt - 2);
            const char* a1 = cA + (size_t)(t + 1) * kstep;
            const char* a2 = last ? nA : cA + (size_t)(t + 2) * kstep; const char* b2 = last ? nB : cB + (size_t)(t + 2) * kstep;
            const char* a3 = a2 + kstep; const char* b3 = b2 + kstep;
            if (last && has_next) S.a_ready(nxt);
            if constexpr (SP2) {
            PG8_LDB(B0, 0, 0); PG8_LDB(B1, 0, 1); PG8_SCHED; PG8_LDA(At, 0, 0); PG8_STAGE(PG8_SA(1, 1), a1 + hstep, voffA);
            PG8_WAIT_V(8); PG8_WAIT_L(0); PG8_BAR; PG8_MMA(0, 0, At, B0); PG8_MMA(0, 1, At, B1); PG8_BAR; PG8_SCHED;
            PG8_LDA(At, 0, 1); PG8_STAGE(PG8_SB(0, 0), b2, voffB); PG8_STAGE(PG8_SB(0, 1), b2 + hstep, voffB); PG8_STAGE(PG8_SA(0, 0), a2, voffA);
            PG8_WAIT_V(8); PG8_WAIT_L(0); PG8_BAR; PG8_MMA(1, 0, At, B0); PG8_MMA(1, 1, At, B1); PG8_BAR; PG8_SCHED;
            PG8_LDB(B0, 1, 0); PG8_LDB(B1, 1, 1); PG8_SCHED; PG8_LDA(At, 1, 0); PG8_STAGE(PG8_SA(0, 1), a2 + hstep, voffA);
            PG8_WAIT_V(8); PG8_WAIT_L(0); PG8_BAR; PG8_MMA(0, 0, At, B0); PG8_MMA(0, 1, At, B1); PG8_BAR; PG8_SCHED;
            PG8_LDA(At, 1, 1); PG8_STAGE(PG8_SB(1, 0), b3, voffB); PG8_STAGE(PG8_SB(1, 1), b3 + hstep, voffB); PG8_STAGE(PG8_SA(1, 0), a3, voffA);
            PG8_WAIT_V(8); PG8_WAIT_L(0); PG8_BAR; PG8_MMA(1, 0, At, B0); PG8_MMA(1, 1, At, B1); PG8_BAR; PG8_SCHED;
            } else {
            PG8_LDB(B0, 0, 0); PG8_SCHED; PG8_LDA(At, 0, 0); PG8_STAGE(PG8_SA(1, 1), a1 + hstep, voffA);
            PG8_WAIT_L(8); PG8_BAR; PG8_WAIT_L(0); PG8_MMA(0, 0, At, B0); PG8_BAR; PG8_SCHED;
            PG8_LDB(B1, 0, 1); PG8_STAGE(PG8_SB(0, 0), b2, voffB);
            PG8_BAR; PG8_WAIT_L(0); PG8_MMA(0, 1, At, B1); PG8_BAR;
            PG8_LDA(At, 0, 1); PG8_STAGE(PG8_SA(0, 0), a2, voffA);
            PG8_BAR; PG8_WAIT_L(0); PG8_MMA(1, 0, At, B0); PG8_BAR; PG8_SCHED;
            PG8_STAGE(PG8_SB(0, 1), b2 + hstep, voffB);
            PG8_WAIT_V(6); PG8_BAR; PG8_MMA(1, 1, At, B1); PG8_BAR;
            PG8_LDB(B0, 1, 0); PG8_SCHED; PG8_LDA(At, 1, 0); PG8_STAGE(PG8_SA(0, 1), a2 + hstep, voffA);
            PG8_WAIT_L(8); PG8_BAR; PG8_WAIT_L(0); PG8_MMA(0, 0, At, B0); PG8_BAR; PG8_SCHED;
            PG8_LDB(B1, 1, 1); PG8_STAGE(PG8_SB(1, 0), b3, voffB);
            PG8_BAR; PG8_WAIT_L(0); PG8_MMA(0, 1, At, B1); PG8_BAR;
            PG8_LDA(At, 1, 1); PG8_STAGE(PG8_SA(1, 0), a3, voffA);
            PG8_BAR; PG8_WAIT_L(0); PG8_MMA(1, 0, At, B0); PG8_BAR; PG8_SCHED;
            PG8_STAGE(PG8_SB(1, 1), b3 + hstep, voffB);
            PG8_WAIT_V(6); PG8_BAR; PG8_MMA(1, 1, At, B1); PG8_BAR;
            }
        }
        if constexpr (ALIGN_EPI) { if (wr == 0) PG8_BAR; }
        if constexpr (!Epi::AFTER_DRAIN) { E(acc, cur, wr, wc, fr, fq); S.done(cur); }
        if (!has_next) break;
#pragma unroll
        for (int a = 0; a < 2; ++a)
#pragma unroll
            for (int b = 0; b < 2; ++b)
#pragma unroll
                for (int m = 0; m < 4; ++m)
#pragma unroll
                    for (int n = 0; n < 2; ++n) acc[a][b][m][n] = (f32x4){0.f, 0.f, 0.f, 0.f};
        cur = nxt; cA = nA; cB = nB; ++ui;
        if constexpr (ALIGN_EPI) { if (wr == 1) PG8_BAR; }
    }
    PG8_WAIT_V(0);
    if constexpr (!ALIGN_EPI) { if (wr == 0) PG8_BAR; }
    PG8_BAR;
    if constexpr (Epi::AFTER_DRAIN) { E.fused(acc, cur, wr, wc, fr, fq, lds, wid, lane); S.done(cur); }
#undef PG8_SA
#undef PG8_SB
#undef PG8_STAGE
#undef PG8_LDA
#undef PG8_LDB
#undef PG8_MMA
#undef PG8_WAIT_V
#undef PG8_WAIT_L
#undef PG8_BAR
#undef PG8_SCHED
}
}
#ifndef GEMM_MASK
#define GEMM_MASK 15
#endif

namespace mk {
using pg8::bf16_t; using pg8::bf16x8; using pg8::f32x4; using pg8::u32x4;
typedef unsigned u32x2 __attribute__((ext_vector_type(2)));

constexpr int D = 1024, NB = 8, SEQ = 2048, DEPTH = 2, NS = 128;
constexpr int MP = NB * SEQ;
constexpr int MT = MP + NS;
constexpr int INW = 2048, FF = 2816, NMOD = 6 * D, MODROWS = 144;
constexpr float RMS_EPS = 1e-6f, LN_EPS = 1e-5f;
constexpr int LDS_BYTES = 132096;

constexpr size_t O_Y = 0;
constexpr size_t O_NAP = (size_t)MT * D;
constexpr size_t O_NBP = O_NAP + (size_t)DEPTH * NB * 30 * 256;
constexpr size_t O_NDP = O_NBP + (size_t)DEPTH * NB * 15 * 256;
constexpr size_t O_NAS = O_NDP + (size_t)DEPTH * NB * 2 * 256;
constexpr size_t O_NBS = O_NAS + (size_t)DEPTH * NS * 30 * 256;
constexpr size_t O_NDS = O_NBS + (size_t)DEPTH * NS * 15 * 256;
constexpr size_t O_NVS = O_NDS + (size_t)DEPTH * NS * 2 * 256;
constexpr size_t O_END = O_NVS + (size_t)DEPTH * NS * 256;

constexpr size_t MiB = 1u << 20;
constexpr size_t WS_WIN = 1 * MiB, WS_WOUT = 9 * MiB, WS_WGU = 13 * MiB, WS_WDN = 35 * MiB, WS_MOD = 46 * MiB, WS_SC = 53 * MiB;
constexpr size_t WS_H = 54 * MiB, WS_PROJ = 87 * MiB, WS_MIX = 152 * MiB, WS_G = 87 * MiB, WS_MF = 185 * MiB, WS_WADA = 185 * MiB, WS_END = 250 * MiB;
static_assert(WS_WIN + 2ull * INW * D * 2 <= WS_WOUT && WS_WOUT + 2ull * D * D * 2 <= WS_WGU && WS_WGU + 2ull * 2 * FF * D * 2 <= WS_WDN && WS_WDN + 2ull * D * FF * 2 <= WS_MOD, "ws map 1");
static_assert(WS_MOD + 2ull * MODROWS * NMOD * 4 <= WS_SC && WS_SC + (size_t)MODROWS * D * 2 <= WS_H && WS_H + (size_t)MT * D * 2 <= WS_PROJ, "ws map 2");
static_assert(WS_PROJ + (size_t)MT * INW * 2 <= WS_MIX && WS_MIX + (size_t)MT * D * 2 <= WS_MF && WS_G + (size_t)MT * FF * 2 <= WS_MF && WS_MF + (size_t)MT * D * 4 <= WS_END && WS_WADA + 2ull * NMOD * D * 2 <= WS_END, "ws map 3");

struct Params {
    const float* in[29];
    float* out;
    unsigned char* ws;
    int ph_lo, ph_hi, coop, pad;
};
enum { I_XP = 0, I_XS, I_CP, I_CS, I_SA, I_SB, I_SD, I_WADA, I_BADA, I_GPREMIX, I_GPOSTMIX, I_WIN, I_CAW, I_CAB, I_LNAG, I_LNAB, I_POOLW, I_POOLS, I_LNCG, I_LNCB,
       I_SGUW, I_SGUB, I_CDW, I_WOUT, I_GPREFFN, I_GPOSTFFN, I_WGATE, I_WUP, I_WDOWN };

__device__ __forceinline__ int otid() { int t = threadIdx.x; asm volatile("" : "+v"(t)); return t; }
#define LDS_WAIT() asm volatile("s_waitcnt lgkmcnt(0)" ::: "memory")

__device__ __forceinline__ float bf2f(unsigned short h) { return __uint_as_float((unsigned)h << 16); }
__device__ __forceinline__ float bflo(unsigned w) { return __uint_as_float(w << 16); }
__device__ __forceinline__ float bfhi(unsigned w) { return __uint_as_float(w & 0xffff0000u); }
__device__ __forceinline__ unsigned pk2(float lo, float hi) { return pg8::cvt_pk_bf16(lo, hi); }
__device__ __forceinline__ unsigned short f2bf(float f) { return (unsigned short)(pk2(f, 0.f) & 0xffffu); }
__device__ __forceinline__ float sigmoid_(float x) { return __builtin_amdgcn_rcpf(1.f + __expf(-x)); }
__device__ __forceinline__ float silu_(float x) { return x * sigmoid_(x); }
__device__ __forceinline__ float wave_sum(float v) {
#pragma unroll
    for (int o = 1; o < 64; o <<= 1) v += __shfl_xor(v, o);
    return v;
}
__device__ __forceinline__ float sum4(f32x4 v) { return (v.x + v.y) + (v.z + v.w); }
__device__ __forceinline__ float dot4(f32x4 v) { return (v.x * v.x + v.y * v.y) + (v.z * v.z + v.w * v.w); }

struct EpiStoreBf16 {
    static constexpr bool PERM = true, AFTER_DRAIN = false;
    bf16_t* O; int ldc;
    __device__ __forceinline__ void operator()(const f32x4 (&acc)[2][2][4][2], const pg8::Unit& u, int wr, int wc, int fr, int fq) const {
        const int row0 = u.pm * 256 + wr * 64 + fr, col0 = u.pn * 256 + wc * 32 + 8 * fq;
#pragma unroll
        for (int ai = 0; ai < 2; ++ai)
#pragma unroll
            for (int m = 0; m < 4; ++m) { bf16_t* rowp = O + (size_t)(row0 + ai * 128 + m * 16) * ldc + col0;
#pragma unroll
                for (int bj = 0; bj < 2; ++bj) { const f32x4 v0 = acc[ai][bj][m][0], v1 = acc[ai][bj][m][1];
                    u32x4 w; w.x = pk2(v0[0], v0[1]); w.y = pk2(v0[2], v0[3]); w.z = pk2(v1[0], v1[1]); w.w = pk2(v1[2], v1[3]);
                    *(u32x4*)(rowp + bj * 128) = w; } }
    }
};
struct EpiStoreF32 {
    static constexpr bool PERM = false, AFTER_DRAIN = false;
    float* O; int ldc;
    __device__ __forceinline__ void operator()(const f32x4 (&acc)[2][2][4][2], const pg8::Unit& u, int wr, int wc, int fr, int fq) const {
        const int row0 = u.pm * 256 + wr * 64 + fr, col0 = u.pn * 256 + wc * 32 + 4 * fq;
#pragma unroll
        for (int ai = 0; ai < 2; ++ai)
#pragma unroll
            for (int m = 0; m < 4; ++m) { float* rowp = O + (size_t)(row0 + ai * 128 + m * 16) * ldc + col0;
#pragma unroll
                for (int bj = 0; bj < 2; ++bj)
#pragma unroll
                    for (int n = 0; n < 2; ++n) *(f32x4*)(rowp + bj * 128 + n * 16) = acc[ai][bj][m][n]; }
    }
};
struct EpiSwiGLU {
    static constexpr bool PERM = true, AFTER_DRAIN = false;
    bf16_t* O;
    __device__ __forceinline__ void operator()(const f32x4 (&acc)[2][2][4][2], const pg8::Unit& u, int wr, int wc, int fr, int fq) const {
        const int row0 = u.pm * 256 + wr * 64 + fr, col0 = u.pn * 128 + wc * 32 + 8 * fq;
#pragma unroll
        for (int ai = 0; ai < 2; ++ai)
#pragma unroll
            for (int m = 0; m < 4; ++m) { bf16_t* rowp = O + (size_t)(row0 + ai * 128 + m * 16) * FF + col0;
                const f32x4 g0 = acc[ai][0][m][0], g1 = acc[ai][0][m][1], u0 = acc[ai][1][m][0], u1 = acc[ai][1][m][1];
                u32x4 w; w.x = pk2(silu_(g0[0]) * u0[0], silu_(g0[1]) * u0[1]); w.y = pk2(silu_(g0[2]) * u0[2], silu_(g0[3]) * u0[3]);
                w.z = pk2(silu_(g1[0]) * u1[0], silu_(g1[1]) * u1[1]); w.w = pk2(silu_(g1[2]) * u1[2], silu_(g1[3]) * u1[3]);
                *(u32x4*)rowp = w; }
    }
};

template <int NMT, int MODE>
__device__ __forceinline__ void small_gemm_item(unsigned char* lds, const bf16_t* A, const bf16_t* B0, const bf16_t* B1, int K, void* out, int ldc, int col0, const float* bias) {
    const int tid = otid(), wid = tid >> 6, lane = tid & 63, fr = lane & 15, fq = lane >> 4;
    const int ksteps = K / 256;
    const int kbeg = wid * ksteps * 32 + 8 * fq;
    constexpr int NACC = NMT * (MODE == 2 ? 2 : 1);
    f32x4 acc[NACC];
#pragma unroll
    for (int i = 0; i < NACC; ++i) acc[i] = (f32x4){0.f, 0.f, 0.f, 0.f};
    const bf16_t* ap = A + (size_t)fr * K + kbeg;
    const bf16_t* bp0 = B0 + (size_t)fr * K + kbeg;
    const bf16_t* bp1 = (MODE == 2) ? B1 + (size_t)fr * K + kbeg : bp0;
    for (int ks = 0; ks < ksteps; ++ks) {
        const bf16x8 b0 = *(const bf16x8*)(bp0 + 32 * ks);
        bf16x8 b1 = b0; if (MODE == 2) b1 = *(const bf16x8*)(bp1 + 32 * ks);
#pragma unroll
        for (int mt = 0; mt < NMT; ++mt) {
            const bf16x8 a = *(const bf16x8*)(ap + (size_t)mt * 16 * K + 32 * ks);
            acc[mt] = __builtin_amdgcn_mfma_f32_16x16x32_bf16(b0, a, acc[mt], 0, 0, 0);
            if (MODE == 2) acc[NMT + mt] = __builtin_amdgcn_mfma_f32_16x16x32_bf16(b1, a, acc[NMT + mt], 0, 0, 0);
        }
    }
    f32x4* red = (f32x4*)lds;
#pragma unroll
    for (int i = 0; i < NACC; ++i) red[(wid * NACC + i) * 64 + lane] = acc[i];
    __syncthreads();
    for (int mt = wid; mt < NMT; mt += 8) {
        f32x4 s = (f32x4){0.f, 0.f, 0.f, 0.f}, s2 = (f32x4){0.f, 0.f, 0.f, 0.f};
#pragma unroll
        for (int w = 0; w < 8; ++w) { s += red[(w * NACC + mt) * 64 + lane]; if (MODE == 2) s2 += red[(w * NACC + NMT + mt) * 64 + lane]; }
        const int row = 16 * mt + fr, col = col0 + 4 * fq;
        if (MODE == 0) { u32x2 w; w.x = pk2(s[0], s[1]); w.y = pk2(s[2], s[3]); *(u32x2*)((bf16_t*)out + (size_t)row * ldc + col) = w; }
        else if (MODE == 1) { if (bias) s += *(const f32x4*)(bias + col); *(f32x4*)((float*)out + (size_t)row * ldc + col) = s; }
        else { u32x2 w; w.x = pk2(silu_(s[0]) * s2[0], silu_(s[1]) * s2[1]); w.y = pk2(silu_(s[2]) * s2[2], silu_(s[3]) * s2[3]); *(u32x2*)((bf16_t*)out + (size_t)row * ldc + col) = w; }
    }
    __syncthreads();
}

__device__ __forceinline__ void transpose_item(const float* W, int N, bf16_t* WT, int K, int k0, int n0, int drow0, float* scr, int lane) {
#pragma unroll 8
    for (int i = 0; i < 32; ++i) { const int kk = 2 * i + (lane >> 5); scr[kk * 33 + (lane & 31)] = W[(size_t)(k0 + kk) * N + n0 + (lane & 31)]; }
    LDS_WAIT();
    const int c = lane & 7;
#pragma unroll
    for (int j = 0; j < 4; ++j) { const int n = (lane >> 3) + 8 * j; const float* s = scr + (8 * c) * 33 + n;
        u32x4 o; o.x = pk2(s[0 * 33], s[1 * 33]); o.y = pk2(s[2 * 33], s[3 * 33]); o.z = pk2(s[4 * 33], s[5 * 33]); o.w = pk2(s[6 * 33], s[7 * 33]);
        *(u32x4*)(WT + (size_t)(drow0 + n) * K + k0 + 8 * c) = o; }
    LDS_WAIT();
}
constexpr int IT_WIN = 16 * 64, IT_WOUT = 16 * 32, IT_WG = 16 * 88, IT_WDN = 44 * 32, IT_WADA = 16 * 192;
constexpr int IT_LAYER = IT_WIN + IT_WOUT + 2 * IT_WG + IT_WDN + IT_WADA;
__device__ __forceinline__ void p0_prologue(const Params& P, unsigned char* lds) {
    const int tid = otid(), wid = tid >> 6, lane = tid & 63;
    float* scr = (float*)(lds + wid * 8448);
    const int gw = blockIdx.x * 8 + wid, NGW = gridDim.x * 8;
    unsigned char* ws = P.ws;
    for (int it = gw; it < DEPTH * IT_LAYER; it += NGW) {
        const int l = it / IT_LAYER; int r = it % IT_LAYER;
        if (r < IT_WIN) { const int kb = r / 64, nb = r % 64; transpose_item(P.in[I_WIN] + (size_t)l * D * INW, INW, (bf16_t*)(ws + WS_WIN) + (size_t)l * INW * D, D, 64 * kb, 32 * nb, 32 * nb, scr, lane); continue; }
        r -= IT_WIN;
        if (r < IT_WOUT) { const int kb = r / 32, nb = r % 32; transpose_item(P.in[I_WOUT] + (size_t)l * D * D, D, (bf16_t*)(ws + WS_WOUT) + (size_t)l * D * D, D, 64 * kb, 32 * nb, 32 * nb, scr, lane); continue; }
        r -= IT_WOUT;
        if (r < 2 * IT_WG) { const int up = r >= IT_WG; if (up) r -= IT_WG; const int kb = r / 88, nb = r % 88, n0 = 32 * nb;
            transpose_item((up ? P.in[I_WUP] : P.in[I_WGATE]) + (size_t)l * D * FF, FF, (bf16_t*)(ws + WS_WGU) + (size_t)l * 2 * FF * D, D, 64 * kb, n0, 256 * (n0 >> 7) + (n0 & 127) + (up ? 128 : 0), scr, lane); continue; }
        r -= 2 * IT_WG;
        if (r < IT_WDN) { const int kb = r / 32, nb = r % 32; transpose_item(P.in[I_WDOWN] + (size_t)l * FF * D, D, (bf16_t*)(ws + WS_WDN) + (size_t)l * D * FF, FF, 64 * kb, 32 * nb, 32 * nb, scr, lane); continue; }
        r -= IT_WDN;
        { const int kb = r / 192, nb = r % 192; transpose_item(P.in[I_WADA] + (size_t)l * D * NMOD, NMOD, (bf16_t*)(ws + WS_WADA) + (size_t)l * NMOD * D, D, 64 * kb, 32 * nb, 32 * nb, scr, lane); }
    }
    bf16_t* SC = (bf16_t*)(ws + WS_SC);
    for (int row = gw; row < MODROWS; row += NGW) {
        const float* c = row < NB ? P.in[I_CP] + (size_t)row * D : (row < NB + NS ? P.in[I_CS] + (size_t)(row - NB) * D : nullptr);
#pragma unroll
        for (int j = 0; j < 4; ++j) { f32x4 v = (f32x4){0.f, 0.f, 0.f, 0.f}; if (c) v = *(const f32x4*)(c + 256 * j + 4 * lane);
            u32x2 w; w.x = pk2(c ? silu_(v.x) : 0.f, c ? silu_(v.y) : 0.f); w.y = pk2(c ? silu_(v.z) : 0.f, c ? silu_(v.w) : 0.f);
            *(u32x2*)(SC + (size_t)row * D + 256 * j + 4 * lane) = w; }
    }
}

__device__ __forceinline__ void norm_phase(const Params& P, int kind, int l) {
    const int tid = otid(), wid = tid >> 6, lane = tid & 63;
    const int gw = blockIdx.x * 8 + wid, NGW = gridDim.x * 8;
    const float* MOD = (const float*)(P.ws + WS_MOD);
    const float* MF = (const float*)(P.ws + WS_MF);
    bf16_t* H = (bf16_t*)(P.ws + WS_H);
    float* X = P.out + O_Y;
    for (int row = gw; row < MT; row += NGW) {
        const int mrow = row < MP ? row / SEQ : NB + (row - MP);
        const float* modp = MOD + ((size_t)l * MODROWS + mrow) * NMOD;
        const float* xin = (l == 0 && kind <= 1) ? (row < MP ? P.in[I_XP] + (size_t)row * D : P.in[I_XS] + (size_t)(row - MP) * D) : X + (size_t)row * D;
        f32x4 xv[4];
#pragma unroll
        for (int j = 0; j < 4; ++j) xv[j] = *(const f32x4*)(xin + 256 * j + 4 * lane);
        if (kind >= 1) {
            f32x4 mv[4]; float ss = 0.f;
#pragma unroll
            for (int j = 0; j < 4; ++j) { mv[j] = *(const f32x4*)(MF + (size_t)row * D + 256 * j + 4 * lane); ss += dot4(mv[j]); }
            const float rs = rsqrtf(wave_sum(ss) * (1.f / D) + RMS_EPS);
            const float* gp = (kind == 1 ? P.in[I_GPOSTMIX] : P.in[I_GPOSTFFN]) + (size_t)l * D;
            const float* gt = modp + (kind == 1 ? 2 * D : 5 * D);
#pragma unroll
            for (int j = 0; j < 4; ++j) { const f32x4 g = *(const f32x4*)(gp + 256 * j + 4 * lane), t = *(const f32x4*)(gt + 256 * j + 4 * lane);
                xv[j] = xv[j] + t * (mv[j] * rs * g);
                *(f32x4*)(X + (size_t)row * D + 256 * j + 4 * lane) = xv[j]; }
        }
        if (kind != 2 || l + 1 < DEPTH) {
            float ss = 0.f;
#pragma unroll
            for (int j = 0; j < 4; ++j) ss += dot4(xv[j]);
            const float rs = rsqrtf(wave_sum(ss) * (1.f / D) + RMS_EPS);
            const float* gp; const float* sc; const float* sh;
            if (kind == 0) { gp = P.in[I_GPREMIX] + (size_t)l * D; sh = modp; sc = modp + D; }
            else if (kind == 1) { gp = P.in[I_GPREFFN] + (size_t)l * D; sh = modp + 3 * D; sc = modp + 4 * D; }
            else { gp = P.in[I_GPREMIX] + (size_t)(l + 1) * D; sh = modp + (size_t)MODROWS * NMOD; sc = sh + D; }
#pragma unroll
            for (int j = 0; j < 4; ++j) { const f32x4 g = *(const f32x4*)(gp + 256 * j + 4 * lane), a = *(const f32x4*)(sc + 256 * j + 4 * lane), b = *(const f32x4*)(sh + 256 * j + 4 * lane);
                const f32x4 h = (xv[j] * rs * g) * (a + 1.f) + b;
                u32x2 w; w.x = pk2(h.x, h.y); w.y = pk2(h.z, h.w);
                *(u32x2*)(H + (size_t)row * D + 256 * j + 4 * lane) = w; }
        }
    }
}

__device__ __forceinline__ void mix_prompt_item(const Params& P, int l, int b, int rb, unsigned char* lds) {
    const int tid = otid(), wid = tid >> 6, lane = tid & 63, fr = lane & 15, fq = lane >> 4;
    const int t0 = 64 * rb; const size_t R0 = (size_t)b * SEQ + t0;
    const bf16_t* PR = (const bf16_t*)(P.ws + WS_PROJ);
    bf16_t* MX = (bf16_t*)(P.ws + WS_MIX);
    float* out = P.out;
    {
        float* ZA = (float*)lds;
        for (int i = wid; i < 94; i += 8) {
            const int t = t0 - 30 + i; f32x4 z = (f32x4){0.f, 0.f, 0.f, 0.f};
            if (t >= 0) { const bf16_t* p = PR + ((size_t)b * SEQ + t) * INW + 4 * lane; const u32x2 av = *(const u32x2*)p, ag = *(const u32x2*)(p + 256);
                z.x = bflo(av.x) * sigmoid_(bflo(ag.x)); z.y = bfhi(av.x) * sigmoid_(bfhi(ag.x)); z.z = bflo(av.y) * sigmoid_(bflo(ag.y)); z.w = bfhi(av.y) * sigmoid_(bfhi(ag.y)); }
            *(f32x4*)(ZA + i * 256 + 4 * lane) = z;
        }
        __syncthreads();
        if (rb == 31) { float* o = out + O_NAP + ((size_t)(l * NB + b) * 30) * 256; for (int idx = tid; idx < 30 * 256; idx += 512) o[idx] = ZA[64 * 256 + idx]; }
        const int c = tid & 255, half = tid >> 8;
        float w[31], acc[32];
        const float* cw = P.in[I_CAW] + (size_t)l * 31 * 256 + c;
#pragma unroll
        for (int k = 0; k < 31; ++k) w[k] = cw[k * 256];
        const float bias = P.in[I_CAB][l * 256 + c];
#pragma unroll
        for (int r = 0; r < 32; ++r) acc[r] = bias;
        const float* zp = ZA + (32 * half) * 256 + c;
#pragma unroll
        for (int i = 0; i < 62; ++i) { const float z = zp[i * 256];
#pragma unroll
            for (int r = 0; r < 32; ++r) { const int k = i - r; if (k >= 0 && k <= 30) acc[r] = fmaf(w[k], z, acc[r]); } }
        __syncthreads();
        float* Y = (float*)lds;
#pragma unroll
        for (int r = 0; r < 32; ++r) Y[(32 * half + r) * 256 + c] = acc[r];
        __syncthreads();
        const f32x4 g = *(const f32x4*)(P.in[I_LNAG] + l * 256 + 4 * lane), bb = *(const f32x4*)(P.in[I_LNAB] + l * 256 + 4 * lane);
        for (int r = wid; r < 64; r += 8) {
            const f32x4 v = *(const f32x4*)(Y + r * 256 + 4 * lane);
            const float mean = wave_sum(sum4(v)) * (1.f / 256.f); const f32x4 d = v - mean;
            const float rstd = rsqrtf(wave_sum(dot4(d)) * (1.f / 256.f) + LN_EPS);
            const f32x4 y = d * rstd * g + bb;
            u32x2 o; o.x = pk2(silu_(y.x), silu_(y.y)); o.y = pk2(silu_(y.z), silu_(y.w));
            *(u32x2*)(MX + (R0 + r) * D + 4 * lane) = o;
        }
        __syncthreads();
    }
    {
        float* ZB = (float*)lds;
        bf16_t* DB = (bf16_t*)(lds + 80896);
        for (int i = wid; i < 79; i += 8) {
            const int t = t0 - 15 + i; f32x4 z = (f32x4){0.f, 0.f, 0.f, 0.f};
            if (t >= 0) { const u32x2 v = *(const u32x2*)(PR + ((size_t)b * SEQ + t) * INW + 512 + 4 * lane); z.x = bflo(v.x); z.y = bfhi(v.x); z.z = bflo(v.y); z.w = bfhi(v.y); }
            *(f32x4*)(ZB + i * 256 + 4 * lane) = z;
        }
        __syncthreads();
        if (rb == 31) { float* o = out + O_NBP + ((size_t)(l * NB + b) * 15) * 256; for (int idx = tid; idx < 15 * 256; idx += 512) o[idx] = ZB[64 * 256 + idx]; }
        {
            const int c = tid & 255, half = tid >> 8, w = 2 << (c >> 6), r0 = 32 * half;
            float sum = 0.f;
            for (int k = 1; k < w; ++k) sum += ZB[(r0 + 15 - k) * 256 + c];
            for (int r = 0; r < 32; ++r) {
                const float z = ZB[(r0 + r + 15) * 256 + c];
                sum += z;
                const int t = t0 + r0 + r; const int cnt = (t + 1 < w) ? t + 1 : w;
                const float d = sum * __builtin_amdgcn_rcpf((float)cnt) - z;
                DB[(r0 + r) * 264 + c] = f2bf(d);
                sum -= ZB[(r0 + r + 16 - w) * 256 + c];
            }
        }
        __syncthreads();
        {
            const int g = wid & 3, th = wid >> 2;
            const float* pw = P.in[I_POOLW] + ((size_t)(l * 4 + g) * 64) * 64;
            bf16x8 wf[4][2];
#pragma unroll
            for (int nt = 0; nt < 4; ++nt)
#pragma unroll
                for (int ks = 0; ks < 2; ++ks) { const float* q = pw + (size_t)(32 * ks + 8 * fq) * 64 + 16 * nt + fr;
                    u32x4 t; t.x = pk2(q[0], q[64]); t.y = pk2(q[128], q[192]); t.z = pk2(q[256], q[320]); t.w = pk2(q[384], q[448]);
                    wf[nt][ks] = __builtin_bit_cast(bf16x8, t); }
            f32x4 acc[2][4];
#pragma unroll
            for (int tt = 0; tt < 2; ++tt)
#pragma unroll
                for (int nt = 0; nt < 4; ++nt) acc[tt][nt] = (f32x4){0.f, 0.f, 0.f, 0.f};
#pragma unroll
            for (int tt = 0; tt < 2; ++tt)
#pragma unroll
                for (int ks = 0; ks < 2; ++ks) { const bf16x8 df = *(const bf16x8*)(DB + (32 * th + 16 * tt + fr) * 264 + 64 * g + 32 * ks + 8 * fq);
#pragma unroll
                    for (int nt = 0; nt < 4; ++nt) acc[tt][nt] = __builtin_amdgcn_mfma_f32_16x16x32_bf16(wf[nt][ks], df, acc[tt][nt], 0, 0, 0); }
#pragma unroll
            for (int tt = 0; tt < 2; ++tt)
#pragma unroll
                for (int nt = 0; nt < 4; ++nt) { const f32x4 sc = *(const f32x4*)(P.in[I_POOLS] + l * 256 + 64 * g + 16 * nt + 4 * fq); const f32x4 o = acc[tt][nt] * sc;
                    u32x2 w; w.x = pk2(o.x, o.y); w.y = pk2(o.z, o.w);
                    *(u32x2*)(MX + (R0 + 32 * th + 16 * tt + fr) * D + 256 + 64 * g + 16 * nt + 4 * fq) = w; }
        }
        __syncthreads();
    }
    {
        const int c2 = tid & 127, q = tid >> 7;
        const float* cw = P.in[I_CDW] + (size_t)l * 3 * 256 + 2 * c2;
        const float w0a = cw[0], w0b = cw[1], w1a = cw[256], w1b = cw[257], w2a = cw[512], w2b = cw[513];
        float zm2a = 0.f, zm2b = 0.f, zm1a = 0.f, zm1b = 0.f;
        for (int rr = -2; rr < 16; ++rr) {
            const int t = t0 + 16 * q + rr; float z0 = 0.f, z1 = 0.f; unsigned dbv = 0u;
            if (t >= 0) { const bf16_t* p = PR + ((size_t)b * SEQ + t) * INW + 2 * c2; const unsigned dc = *(const unsigned*)(p + 1536), dh = *(const unsigned*)(p + 1792);
                z0 = bflo(dc) * bflo(dh); z1 = bfhi(dc) * bfhi(dh); if (rr >= 0) dbv = *(const unsigned*)(p + 1280); }
            if (rr >= 0) {
                const float y0 = bflo(dbv) * (w0a * zm2a + w1a * zm1a + w2a * z0), y1 = bfhi(dbv) * (w0b * zm2b + w1b * zm1b + w2b * z1);
                *(unsigned*)(MX + (R0 + 16 * q + rr) * D + 768 + 2 * c2) = pk2(y0, y1);
                if (t >= SEQ - 2) { float* o = out + O_NDP + ((size_t)(l * NB + b) * 2 + (t - (SEQ - 2))) * 256 + 2 * c2; o[0] = z0; o[1] = z1; }
            }
            zm2a = zm1a; zm2b = zm1b; zm1a = z0; zm1b = z1;
        }
    }
    {
        const int n = rb >> 1, hf = rb & 1, nrows = 64 * (hf + 1);
        const size_t C0 = (size_t)b * SEQ + 128 * n;
        bf16_t* VT = (bf16_t*)lds;
        const float* lg = P.in[I_LNCG] + l * 256; const float* lb = P.in[I_LNCB] + l * 256;
        const float g0 = lg[lane], g1 = lg[lane + 64], g2 = lg[lane + 128], g3 = lg[lane + 192], b0 = lb[lane], b1 = lb[lane + 64], b2 = lb[lane + 128], b3 = lb[lane + 192];
        for (int j = wid; j < nrows; j += 8) {
            const bf16_t* p = PR + (C0 + j) * INW + 1024 + lane;
            const float v0 = bf2f(p[0]), v1 = bf2f(p[64]), v2 = bf2f(p[128]), v3 = bf2f(p[192]);
            const float mean = wave_sum((v0 + v1) + (v2 + v3)) * (1.f / 256.f);
            const float d0 = v0 - mean, d1 = v1 - mean, d2 = v2 - mean, d3 = v3 - mean;
            const float rstd = rsqrtf(wave_sum((d0 * d0 + d1 * d1) + (d2 * d2 + d3 * d3)) * (1.f / 256.f) + LN_EPS);
            VT[(lane) * 136 + j] = f2bf(d0 * rstd * g0 + b0); VT[(lane + 64) * 136 + j] = f2bf(d1 * rstd * g1 + b1);
            VT[(lane + 128) * 136 + j] = f2bf(d2 * rstd * g2 + b2); VT[(lane + 192) * 136 + j] = f2bf(d3 * rstd * g3 + b3);
        }
        __syncthreads();
        const int h = wid & 3, I0 = 64 * hf + 32 * (wid >> 2);
        const float* W = P.in[I_SGUW] + ((size_t)(l * 4 + h) * 128) * 128;
        f32x4 acc[2][4];
#pragma unroll
        for (int it = 0; it < 2; ++it)
#pragma unroll
            for (int nt = 0; nt < 4; ++nt) acc[it][nt] = (f32x4){0.f, 0.f, 0.f, 0.f};
#pragma unroll
        for (int it = 0; it < 2; ++it) {
            const int i0 = I0 + 16 * it, i = i0 + fr, nks = (i0 >> 5) + 1;
            for (int ks = 0; ks < nks; ++ks) {
                const int j0 = 32 * ks + 8 * fq;
                f32x4 wa = *(const f32x4*)(W + (size_t)i * 128 + j0), wb = *(const f32x4*)(W + (size_t)i * 128 + j0 + 4);
                wa.x = (j0 + 0 <= i) ? wa.x : 0.f; wa.y = (j0 + 1 <= i) ? wa.y : 0.f; wa.z = (j0 + 2 <= i) ? wa.z : 0.f; wa.w = (j0 + 3 <= i) ? wa.w : 0.f;
                wb.x = (j0 + 4 <= i) ? wb.x : 0.f; wb.y = (j0 + 5 <= i) ? wb.y : 0.f; wb.z = (j0 + 6 <= i) ? wb.z : 0.f; wb.w = (j0 + 7 <= i) ? wb.w : 0.f;
                u32x4 t; t.x = pk2(wa.x, wa.y); t.y = pk2(wa.z, wa.w); t.z = pk2(wb.x, wb.y); t.w = pk2(wb.z, wb.w);
                const bf16x8 wfrag = __builtin_bit_cast(bf16x8, t);
#pragma unroll
                for (int nt = 0; nt < 4; ++nt) { const bf16x8 vf = *(const bf16x8*)(VT + (64 * h + 16 * nt + fr) * 136 + j0);
                    acc[it][nt] = __builtin_amdgcn_mfma_f32_16x16x32_bf16(vf, wfrag, acc[it][nt], 0, 0, 0); }
            }
        }
#pragma unroll
        for (int it = 0; it < 2; ++it) {
            const int i = I0 + 16 * it + fr; const float bs = P.in[I_SGUB][(l * 4 + h) * 128 + i]; const size_t row = C0 + i;
#pragma unroll
            for (int nt = 0; nt < 4; ++nt) { const int cc = 64 * h + 16 * nt + 4 * fq; const u32x2 cu = *(const u32x2*)(PR + row * INW + 768 + cc);
                const f32x4 a = acc[it][nt] + bs;
                u32x2 o; o.x = pk2(bflo(cu.x) * a.x, bfhi(cu.x) * a.y); o.y = pk2(bflo(cu.y) * a.z, bfhi(cu.y) * a.w);
                *(u32x2*)(MX + row * D + 512 + cc) = o; }
        }
        __syncthreads();
    }
}

__device__ __forceinline__ void mix_sample_item(const Params& P, int l, int pair, unsigned char* lds) {
    const int tid = otid(), wid = tid >> 6, lane = tid & 63, c = tid & 255, hs = tid >> 8, s = 2 * pair + hs;
    const bf16_t* PR = (const bf16_t*)(P.ws + WS_PROJ);
    bf16_t* MX = (bf16_t*)(P.ws + WS_MIX);
    float* out = P.out;
    const size_t row = (size_t)MP + s;
    const bf16_t* p = PR + row * INW + c;
    const float av = bf2f(p[0]), ag = bf2f(p[256]), bi = bf2f(p[512]), cu = bf2f(p[768]), cv = bf2f(p[1024]), db = bf2f(p[1280]), dc = bf2f(p[1536]), dh = bf2f(p[1792]);
    const float za = av * sigmoid_(ag);
    const float* sa = P.in[I_SA] + ((size_t)(l * NS + s) * 30) * 256 + c;
    float* na = out + O_NAS + ((size_t)(l * NS + s) * 30) * 256 + c;
    const float* caw = P.in[I_CAW] + (size_t)l * 31 * 256 + c;
    float ya = P.in[I_CAB][l * 256 + c];
    for (int k = 0; k < 30; ++k) { const float z = sa[k * 256]; ya = fmaf(caw[k * 256], z, ya); if (k >= 1) na[(k - 1) * 256] = z; }
    ya = fmaf(caw[30 * 256], za, ya); na[29 * 256] = za;
    const int g = c >> 6, w = 2 << g;
    const float* sb = P.in[I_SB] + ((size_t)(l * NS + s) * 15) * 256 + c;
    float* nb = out + O_NBS + ((size_t)(l * NS + s) * 15) * 256 + c;
    float sum = bi;
    for (int k = 0; k < 15; ++k) { const float z = sb[k * 256]; if (k >= 16 - w) sum += z; if (k >= 1) nb[(k - 1) * 256] = z; }
    nb[14 * 256] = bi;
    const float dpool = sum * (1.f / (float)w) - bi;
    const float zd = dc * dh;
    const float* sd = P.in[I_SD] + ((size_t)(l * NS + s) * 2) * 256 + c;
    float* nd = out + O_NDS + ((size_t)(l * NS + s) * 2) * 256 + c;
    const float s0 = sd[0], s1 = sd[256];
    const float* cdw = P.in[I_CDW] + (size_t)l * 3 * 256 + c;
    const float yd = db * (cdw[0] * s0 + cdw[256] * s1 + cdw[512] * zd);
    nd[0] = s1; nd[256] = zd;
    const float r0 = wave_sum(ya), r1 = wave_sum(cv);
    float* RED = (float*)lds;
    float* DL = RED + 64;
    if (lane == 0) { RED[wid * 4 + 0] = r0; RED[wid * 4 + 1] = r1; }
    DL[hs * 256 + c] = dpool;
    __syncthreads();
    const int wb = hs * 16;
    const float meanA = ((RED[wb + 0] + RED[wb + 4]) + (RED[wb + 8] + RED[wb + 12])) * (1.f / 256.f);
    const float meanC = ((RED[wb + 1] + RED[wb + 5]) + (RED[wb + 9] + RED[wb + 13])) * (1.f / 256.f);
    const float da = ya - meanA, dcv = cv - meanC;
    const float q0 = wave_sum(da * da), q1 = wave_sum(dcv * dcv);
    if (lane == 0) { RED[wid * 4 + 2] = q0; RED[wid * 4 + 3] = q1; }
    __syncthreads();
    const float rstdA = rsqrtf(((RED[wb + 2] + RED[wb + 6]) + (RED[wb + 10] + RED[wb + 14])) * (1.f / 256.f) + LN_EPS);
    const float rstdC = rsqrtf(((RED[wb + 3] + RED[wb + 7]) + (RED[wb + 11] + RED[wb + 15])) * (1.f / 256.f) + LN_EPS);
    const float yA = silu_(da * rstdA * P.in[I_LNAG][l * 256 + c] + P.in[I_LNAB][l * 256 + c]);
    const float vn = dcv * rstdC * P.in[I_LNCG][l * 256 + c] + P.in[I_LNCB][l * 256 + c];
    out[O_NVS + (size_t)(l * NS + s) * 256 + c] = vn;
    const float yc = cu * (P.in[I_SGUW][((size_t)(l * 4 + g) * 128) * 128] * vn + P.in[I_SGUB][(l * 4 + g) * 128]);
    const float* pw = P.in[I_POOLW] + ((size_t)(l * 4 + g) * 64) * 64 + (c & 63);
    float yb = 0.f;
    for (int cc = 0; cc < 64; ++cc) yb = fmaf(DL[hs * 256 + 64 * g + cc], pw[cc * 64], yb);
    yb *= P.in[I_POOLS][l * 256 + c];
    MX[row * D + c] = f2bf(yA); MX[row * D + 256 + c] = f2bf(yb); MX[row * D + 512 + c] = f2bf(yc); MX[row * D + 768 + c] = f2bf(yd);
    __syncthreads();
}

__global__ void __launch_bounds__(512, 2) mk_fwd(Params P) {
    extern __shared__ __attribute__((aligned(16))) unsigned char lds[];
    const int G = gridDim.x, bx = blockIdx.x;
    unsigned char* ws = P.ws;
    bf16_t* const H = (bf16_t*)(ws + WS_H); bf16_t* const PROJ = (bf16_t*)(ws + WS_PROJ); bf16_t* const MIX = (bf16_t*)(ws + WS_MIX); bf16_t* const GB = (bf16_t*)(ws + WS_G);
    float* const MF = (float*)(ws + WS_MF);
    PG8_LAS unsigned char* ring = (PG8_LAS unsigned char*)lds;
    int ph = 0;
#define IN_PH() (P.ph_lo <= ph && ph < P.ph_hi)
#define SEAM() do { if (P.coop && P.ph_lo <= ph && ph + 1 < P.ph_hi) cg::this_grid().sync(); ++ph; } while (0)
    #ifndef NO_P0
    if (IN_PH()) p0_prologue(P, lds);
#endif
    SEAM();
    if (IN_PH()) {

#ifndef NO_MOD
        for (int it = bx; it < DEPTH * (NMOD / 16); it += G) { const int l = it / (NMOD / 16), nt = it % (NMOD / 16);
            small_gemm_item<9, 1>(lds, (const bf16_t*)(ws + WS_SC), (const bf16_t*)(ws + WS_WADA) + ((size_t)l * NMOD + 16 * nt) * D, nullptr, D,
                                  (float*)(ws + WS_MOD) + (size_t)l * MODROWS * NMOD, NMOD, 16 * nt, P.in[I_BADA] + (size_t)l * NMOD); }
#endif

    }
    SEAM();
    for (int l = 0; l < DEPTH; ++l) {
        const bf16_t* WIN = (const bf16_t*)(ws + WS_WIN) + (size_t)l * INW * D; const bf16_t* WOUT = (const bf16_t*)(ws + WS_WOUT) + (size_t)l * D * D;
        const bf16_t* WGU = (const bf16_t*)(ws + WS_WGU) + (size_t)l * 2 * FF * D; const bf16_t* WDN = (const bf16_t*)(ws + WS_WDN) + (size_t)l * D * FF;
        if (l == 0) {
#ifndef NO_NORM
 if (IN_PH()) norm_phase(P, 0, 0);
#endif
 SEAM(); }
        if (IN_PH()) {
            pg8::Gemm g{H, WIN, MP, INW, D}; pg8::StaticOrder S; S.init(MP, INW, G, bx); EpiStoreBf16 E{PROJ, INW};
#if !defined(NO_GEMM) && (GEMM_MASK & 1)
            pg8::gemm_phase<EpiStoreBf16, pg8::StaticOrder, true, true>(ring, g, S, E);
#endif
#ifndef NO_SMALL
            for (int it = bx; it < INW / 16; it += G) small_gemm_item<8, 0>(lds, H + (size_t)MP * D, WIN + (size_t)16 * it * D, nullptr, D, PROJ + (size_t)MP * INW, INW, 16 * it, nullptr);
#endif
        }
        SEAM();
        if (IN_PH()) {
            for (int it = bx; it < NB * 32 + NS / 2; it += G) {
#ifndef NO_MIXP
 if (it < NB * 32) mix_prompt_item(P, l, it >> 5, it & 31, lds);
#endif
#ifndef NO_MIXS
 if (it >= NB * 32) mix_sample_item(P, l, it - NB * 32, lds);
#endif
 }
        }
        SEAM();
        if (IN_PH()) {
            pg8::Gemm g{MIX, WOUT, MP, D, D}; pg8::StaticOrder S; S.init(MP, D, G, bx); EpiStoreF32 E{MF, D};
#if !defined(NO_GEMM) && (GEMM_MASK & 2)
            pg8::gemm_phase<EpiStoreF32, pg8::StaticOrder, true, true>(ring, g, S, E);
#endif
#ifndef NO_SMALL
            for (int it = bx; it < D / 16; it += G) small_gemm_item<8, 1>(lds, MIX + (size_t)MP * D, WOUT + (size_t)16 * it * D, nullptr, D, MF + (size_t)MP * D, D, 16 * it, nullptr);
#endif
        }
        SEAM();
#ifndef NO_NORM
        if (IN_PH()) norm_phase(P, 1, l);
#endif
        SEAM();
        if (IN_PH()) {
            pg8::Gemm g{H, WGU, MP, 2 * FF, D}; pg8::StaticOrder S; S.init(MP, 2 * FF, G, bx); EpiSwiGLU E{GB};
#if !defined(NO_GEMM) && (GEMM_MASK & 4)
            pg8::gemm_phase<EpiSwiGLU, pg8::StaticOrder, true, true>(ring, g, S, E);
#endif
#ifndef NO_SMALL
            for (int it = (bx + G / 2) % G; it < FF / 16; it += G) { const int ff0 = 16 * it; const bf16_t* b0 = WGU + (size_t)(256 * (ff0 >> 7) + (ff0 & 127)) * D;
                small_gemm_item<8, 2>(lds, H + (size_t)MP * D, b0, b0 + (size_t)128 * D, D, GB + (size_t)MP * FF, FF, ff0, nullptr); }
#endif
        }
        SEAM();
        if (IN_PH()) {
            pg8::Gemm g{GB, WDN, MP, D, FF}; pg8::StaticOrder S; S.init(MP, D, G, bx); EpiStoreF32 E{MF, D};
#if !defined(NO_GEMM) && (GEMM_MASK & 8)
            pg8::gemm_phase<EpiStoreF32, pg8::StaticOrder, true, true>(ring, g, S, E);
#endif
#ifndef NO_SMALL
            for (int it = bx; it < D / 16; it += G) small_gemm_item<8, 1>(lds, GB + (size_t)MP * FF, WDN + (size_t)16 * it * FF, nullptr, FF, MF + (size_t)MP * D, D, 16 * it, nullptr);
#endif
        }
        SEAM();
#ifndef NO_NORM
        if (IN_PH()) norm_phase(P, 2, l);
#endif
        SEAM();
    }
#undef IN_PH
#undef SEAM
}
constexpr int N_PHASES = 2 + 1 + 7 * DEPTH;
}

#ifndef GEMM_MASK
#define GEMM_MASK 15
#endif
#ifndef MK_MULTI
#define MK_MULTI 0
#endif
extern "C" void kernel_launch(void* const* d_in, const int* in_sizes, int n_in, void* d_out, int out_size, void* d_ws, size_t ws_size, hipStream_t stream) {
    using namespace mk;
    static int grid = 0;
    if (grid == 0) {
        if (n_in != 29 || (size_t)out_size != O_END || ws_size < WS_END) { fprintf(stderr, "kernel_launch: unexpected shapes: n_in %d out %d ws %zu\n", n_in, out_size, ws_size); grid = -1; return; }
        int dev = 0, cus = 0, per_cu = 0;
        hipGetDevice(&dev); hipDeviceGetAttribute(&cus, hipDeviceAttributeMultiprocessorCount, dev);
        if (hipFuncSetAttribute((const void*)mk_fwd, hipFuncAttributeMaxDynamicSharedMemorySize, LDS_BYTES) != hipSuccess) { fprintf(stderr, "kernel_launch: hipFuncSetAttribute failed\n"); grid = -1; return; }
        if (hipOccupancyMaxActiveBlocksPerMultiprocessor(&per_cu, (const void*)mk_fwd, 512, LDS_BYTES) != hipSuccess || per_cu < 1) { fprintf(stderr, "kernel_launch: occupancy query says %d\n", per_cu); per_cu = 1; }
        (void)hipGetLastError();
        grid = cus * per_cu;
        fprintf(stderr, "kernel_launch: grid %d (cus %d x %d)\n", grid, cus, per_cu);
    }
    if (grid < 0) return;
    Params p{};
    for (int i = 0; i < 29; ++i) p.in[i] = (const float*)d_in[i];
    p.out = (float*)d_out; p.ws = (unsigned char*)d_ws;
#if MK_MULTI
    for (int ph = 0; ph < N_PHASES; ++ph) { p.ph_lo = ph; p.ph_hi = ph + 1; p.coop = 0; hipLaunchKernelGGL(mk_fwd, dim3(grid), dim3(512), LDS_BYTES, stream, p); }
#else
    p.ph_lo = 0; p.ph_hi = N_PHASES; p.coop = 1;
    void* args[] = {&p};
    hipError_t e = hipLaunchCooperativeKernel((void*)mk_fwd, dim3(grid), dim3(512), args, LDS_BYTES, stream);
    if (e != hipSuccess) fprintf(stderr, "kernel_launch: cooperative launch failed: %s (grid %d)\n", hipGetErrorString(e), grid);
#endif
}
```

```cpp
#include <hip/hip_runtime.h>
#include <hip/hip_cooperative_groups.h>
#include <cstdio>
#include <cstdint>
namespace cg = cooperative_groups;
namespace pg8 {
#define PG8_LAS __attribute__((address_space(3)))
typedef unsigned short bf16_t;
typedef short bf16x8 __attribute__((ext_vector_type(8)));
typedef float f32x4 __attribute__((ext_vector_type(4)));
typedef unsigned u32x4 __attribute__((ext_vector_type(4)));
constexpr int BM = 256, BK = 64, HALF = 128, HTB = HALF * BK * 2  , STAGE_BYTES = 8 * HTB, NXCD = 8, WGM = 8;

__host__ __device__ __forceinline__ int lds_byte(int r, int c) { const int st = (r >> 4) * 2 + (c >> 5), rr = r & 15, cc = c & 31, ob = rr * 64 + cc * 2; return st * 1024 + (ob ^ (((ob >> 9) & 1) << 5)); }
__host__ __device__ __forceinline__ void stage_rc(int b, int& R, int& C) { const int st = b / 1024, sb = b % 1024, swz = sb ^ (((sb >> 9) & 1) << 5); R = (st >> 1) * 16 + swz / 64; C = (st & 1) * 32 + (swz % 64) / 2; }
__host__ __device__ __forceinline__ int perm32(int rho) { const int n = rho >> 4, i = rho & 15; return 8 * (i >> 2) + 4 * n + (i & 3); }

struct Unit { int pm, pn; };
struct Gemm { const bf16_t* A; const bf16_t* Bt; int M, N, K; };

struct StaticOrder {
    int nM, nN, nwg, G, c;
    __host__ __device__ void init(int M, int N, int G_, int c_) { nM = M / BM; nN = N / BM; nwg = nM * nN; G = G_; c = c_; }
    __host__ __device__ bool next(int i, Unit& u) const {
        const long L = (long)i * G + c; if (L >= nwg) return false;
        int wgid = (int)L; { const int q = nwg / NXCD, r = nwg % NXCD, xcd = wgid % NXCD, off = wgid / NXCD; wgid = (xcd < r ? xcd * (q + 1) : r * (q + 1) + (xcd - r) * q) + off; }
        const int nig = WGM * nN, gid = wgid / nig, fm = gid * WGM, gsz = (nM - fm) < WGM ? (nM - fm) : WGM;
        u.pm = fm + ((wgid % nig) % gsz); u.pn = (wgid % nig) / gsz; return true;
    }
    __device__ __forceinline__ void a_ready(const Unit&) const {}
    __device__ __forceinline__ void done(const Unit&) const {}
};
__device__ __forceinline__ unsigned cvt_pk_bf16(float lo, float hi) { unsigned r; asm volatile("v_cvt_pk_bf16_f32 %0, %1, %2" : "=v"(r) : "v"(lo), "v"(hi)); return r; }
template <class Epi, class Sched, bool ALIGN_EPI = false, bool SP2 = false>
__device__ __forceinline__ void gemm_phase(PG8_LAS unsigned char* lds, const Gemm g, const Sched& S, const Epi& E) {
    int tid_ = threadIdx.x; asm volatile("" : "+v"(tid_)); const int tid = tid_, wid = __builtin_amdgcn_readfirstlane(tid >> 6), lane = tid & 63, wr = wid >> 2, wc = wid & 3, fr = lane & 15, fq = lane >> 4;
    const int K = g.K, nt = K / BK;
    unsigned voffA[2], voffB[2];
#pragma unroll
    for (int i = 0; i < 2; ++i) { int R, C; stage_rc(tid * 16 + i * 8192, R, C); const int Rb = Epi::PERM ? ((R & ~31) + perm32(R & 31)) : R;
        voffA[i] = (unsigned)(R * K + C) * 2u; voffB[i] = (unsigned)(Rb * K + C) * 2u; }
    const size_t kstep = (size_t)(BK * 2);
    const size_t hstep = (size_t)HALF * K * 2;
    const size_t tstep = 2 * hstep;
    const unsigned ldsw = (unsigned)wid * 1024u;
    const int aoff = lds_byte(wr * 64 + fr, fq * 8), boff = lds_byte(wc * 32 + fr, fq * 8);
#define PG8_SA(b, h) (((b) * 2 + (h)) * HTB)
#define PG8_SB(b, h) ((4 + (b) * 2 + (h)) * HTB)
#define PG8_STAGE(bufoff, gbase, voff) do { _Pragma("unroll") for (int _i = 0; _i < 2; ++_i) \
        __builtin_amdgcn_global_load_lds((const unsigned*)((const char*)(gbase) + (voff)[_i]), (PG8_LAS unsigned*)(lds + (bufoff) + ldsw + _i * 8192), 16, 0, 0); } while (0)
#define PG8_LDA(dst, b, h) do { _Pragma("unroll") for (int m = 0; m < 4; ++m) _Pragma("unroll") for (int k = 0; k < 2; ++k) dst[m][k] = *(const PG8_LAS bf16x8*)(lds + PG8_SA(b, h) + aoff + m * 2048 + k * 1024); } while (0)
#define PG8_LDB(dst, b, h) do { _Pragma("unroll") for (int n = 0; n < 2; ++n) _Pragma("unroll") for (int k = 0; k < 2; ++k) dst[n][k] = *(const PG8_LAS bf16x8*)(lds + PG8_SB(b, h) + boff + n * 2048 + k * 1024); } while (0)
#define PG8_MMA(ai, bj, At, Bt) do { __builtin_amdgcn_s_setprio(1); _Pragma("unroll") for (int m = 0; m < 4; ++m) _Pragma("unroll") for (int n = 0; n < 2; ++n) _Pragma("unroll") for (int k = 0; k < 2; ++k) \
        acc[ai][bj][m][n] = __builtin_amdgcn_mfma_f32_16x16x32_bf16(Bt[n][k], At[m][k], acc[ai][bj][m][n], 0, 0, 0); __builtin_amdgcn_s_setprio(0); } while (0)
#define PG8_WAIT_V(n) asm volatile("s_waitcnt vmcnt(" #n ")" ::: "memory")
#define PG8_WAIT_L(n) asm volatile("s_waitcnt lgkmcnt(" #n ")" ::: "memory")
#define PG8_BAR __builtin_amdgcn_s_barrier()
#define PG8_SCHED __builtin_amdgcn_sched_barrier(0)
    Unit cur, nxt; int ui = 0;
    if (!S.next(0, cur)) return;
    f32x4 acc[2][2][4][2];
#pragma unroll
    for (int a = 0; a < 2; ++a)
#pragma unroll
        for (int b = 0; b < 2; ++b)
#pragma unroll
            for (int m = 0; m < 4; ++m)
#pragma unroll
                for (int n = 0; n < 2; ++n) acc[a][b][m][n] = (f32x4){0.f, 0.f, 0.f, 0.f};
    bf16x8 At[4][2], B0[2][2], B1[2][2];
    const char* cA = (const char*)g.A + (size_t)cur.pm * tstep; const char* cB = (const char*)g.Bt + (size_t)cur.pn * tstep;
    S.a_ready(cur);
    if constexpr (SP2) {
        PG8_STAGE(PG8_SB(0, 0), cB, voffB); PG8_STAGE(PG8_SB(0, 1), cB + hstep, voffB); PG8_STAGE(PG8_SA(0, 0), cA, voffA); PG8_STAGE(PG8_SA(0, 1), cA + hstep, voffA);
        if (wr == 1) PG8_BAR;
        PG8_WAIT_V(2); PG8_BAR;
        PG8_STAGE(PG8_SB(1, 0), cB + kstep, voffB); PG8_STAGE(PG8_SA(1, 0), cA + kstep, voffA); PG8_STAGE(PG8_SB(1, 1), cB + hstep + kstep, voffB);
        PG8_WAIT_V(6); PG8_BAR;
    } else {
        PG8_STAGE(PG8_SB(0, 0), cB, voffB); PG8_STAGE(PG8_SA(0, 0), cA, voffA); PG8_STAGE(PG8_SB(0, 1), cB + hstep, voffB); PG8_STAGE(PG8_SA(0, 1), cA + hstep, voffA);
        if (wr == 1) PG8_BAR;
        PG8_WAIT_V(4); PG8_BAR;
        PG8_STAGE(PG8_SB(1, 0), cB + kstep, voffB); PG8_STAGE(PG8_SA(1, 0), cA + kstep, voffA); PG8_STAGE(PG8_SB(1, 1), cB + hstep + kstep, voffB);
        PG8_WAIT_V(6); PG8_BAR;
    }
    for (;;) {
        const bool has_next = S.next(ui + 1, nxt);
        const char* nA = has_next ? (const char*)g.A + (size_t)nxt.pm * tstep : cA; const char* nB = has_next ? (const char*)g.Bt + (size_t)nxt.pn * tstep : cB;
        for (int t = 0; t < nt; t += 2) {
            const bool last = (t == nt - 2);
            const char* a1 = cA + (size_t)(t + 1) * kstep;
            const char* a2 = last ? nA : cA + (size_t)(t + 2) * kstep; const char* b2 = last ? nB : cB + (size_t)(t + 2) * kstep;
            const char* a3 = a2 + kstep; const char* b3 = b2 + kstep;
            if (last && has_next) S.a_ready(nxt);
            if constexpr (SP2) {
            PG8_LDB(B0, 0, 0); PG8_LDB(B1, 0, 1); PG8_SCHED; PG8_LDA(At, 0, 0); PG8_STAGE(PG8_SA(1, 1), a1 + hstep, voffA);
            PG8_WAIT_V(8); PG8_WAIT_L(0); PG8_BAR; PG8_MMA(0, 0, At, B0); PG8_MMA(0, 1, At, B1); PG8_BAR; PG8_SCHED;
            PG8_LDA(At, 0, 1); PG8_STAGE(PG8_SB(0, 0), b2, voffB); PG8_STAGE(PG8_SB(0, 1), b2 + hstep, voffB); PG8_STAGE(PG8_SA(0, 0), a2, voffA);
            PG8_WAIT_V(8); PG8_WAIT_L(0); PG8_BAR; PG8_MMA(1, 0, At, B0); PG8_MMA(1, 1, At, B1); PG8_BAR; PG8_SCHED;
            PG8_LDB(B0, 1, 0); PG8_LDB(B1, 1, 1); PG8_SCHED; PG8_LDA(At, 1, 0); PG8_STAGE(PG8_SA(0, 1), a2 + hstep, voffA);
            PG8_WAIT_V(8); PG8_WAIT_L(0); PG8_BAR; PG8_MMA(0, 0, At, B0); PG8_MMA(0, 1, At, B1); PG8_BAR; PG8_SCHED;
            PG8_LDA(At, 1, 1); PG8_STAGE(PG8_SB(1, 0), b3, voffB); PG8_STAGE(PG8_SB(1, 1), b3 + hstep, voffB); PG8_STAGE(PG8_SA(1, 0), a3, voffA);
            PG8_WAIT_V(8); PG8_WAIT_L(0); PG8_BAR; PG8_MMA(1, 0, At, B0); PG8_MMA(1, 1, At, B1); PG8_BAR; PG8_SCHED;
            } else {
            PG8_LDB(B0, 0, 0); PG8_SCHED; PG8_LDA(At, 0, 0); PG8_STAGE(PG8_SA(1, 1), a1 + hstep, voffA);
            PG8_WAIT_L(8); PG8_BAR; PG8_WAIT_L(0); PG8_MMA(0, 0, At, B0); PG8_BAR; PG8_SCHED;
            PG8_LDB(B1, 0, 1); PG8_STAGE(PG8_SB(0, 0), b2, voffB);
            PG8_BAR; PG8_WAIT_L(0); PG8_MMA(0, 1, At, B1); PG8_BAR;
            PG8_LDA(At, 0, 1); PG8_STAGE(PG8_SA(0, 0), a2, voffA);
            PG8_BAR; PG8_WAIT_L(0); PG8_MMA(1, 0, At, B0); PG8_BAR; PG8_SCHED;
            PG8_STAGE(PG8_SB(0, 1), b2 + hstep, voffB);
            PG8_WAIT_V(6); PG8_BAR; PG8_MMA(1, 1, At, B1); PG8_BAR;
            PG8_LDB(B0, 1, 0); PG8_SCHED; PG8_LDA(At, 1, 0); PG8_STAGE(PG8_SA(0, 1), a2 + hstep, voffA);
            PG8_WAIT_L(8); PG8_BAR; PG8_WAIT_L(0); PG8_MMA(0, 0, At, B0); PG8_BAR; PG8_SCHED;
            PG8_LDB(B1, 1, 1); PG8_STAGE(PG8_SB(1, 0), b3, voffB);
            PG8_BAR; PG8_WAIT_L(0); PG8_MMA(0, 1, At, B1); PG8_BAR;
            PG8_LDA(At, 1, 1); PG8_STAGE(PG8_SA(1, 0), a3, voffA);
            PG8_BAR; PG8_WAIT_L(0); PG8_MMA(1, 0, At, B0); PG8_BAR; PG8_SCHED;
            PG8_STAGE(PG8_SB(1, 1), b3 + hstep, voffB);
            PG8_WAIT_V(6); PG8_BAR; PG8_MMA(1, 1, At, B1); PG8_BAR;
            }
        }
        if constexpr (ALIGN_EPI) { if (wr == 0) PG8_BAR; }
        if constexpr (!Epi::AFTER_DRAIN) { E(acc, cur, wr, wc, fr, fq); S.done(cur); }
        if (!has_next) break;
#pragma unroll
        for (int a = 0; a < 2; ++a)
#pragma unroll
            for (int b = 0; b < 2; ++b)
#pragma unroll
                for (int m = 0; m < 4; ++m)
#pragma unroll
                    for (int n = 0; n < 2; ++n) acc[a][b][m][n] = (f32x4){0.f, 0.f, 0.f, 0.f};
        cur = nxt; cA = nA; cB = nB; ++ui;
        if constexpr (ALIGN_EPI) { if (wr == 1) PG8_BAR; }
    }
    PG8_WAIT_V(0);
    if constexpr (!ALIGN_EPI) { if (wr == 0) PG8_BAR; }
    PG8_BAR;
    if constexpr (Epi::AFTER_DRAIN) { E.fused(acc, cur, wr, wc, fr, fq, lds, wid, lane); S.done(cur); }
#undef PG8_SA
#undef PG8_SB
#undef PG8_STAGE
#undef PG8_LDA
#undef PG8_LDB
#undef PG8_MMA
#undef PG8_WAIT_V
#undef PG8_WAIT_L
#undef PG8_BAR
#undef PG8_SCHED
}
}
#define LAS __attribute__((address_space(3)))
#define XB_TMO      128
#define XB_XCNT(j)  (256  + 64 * (j))
#define XB_XSUB(j)  (1280 + 64 * (j))
#define XB_XGEN(j)  (2304 + 64 * (j))
#define XB_TOP      3328
#define XB_TOPGEN   3392
#define XCD_BAR_WORDS 3456
#define XB_SPIN_CAP (1u << 18)

__device__ __forceinline__ unsigned xb_ld(unsigned* p)              { return __hip_atomic_load(p, __ATOMIC_RELAXED, __HIP_MEMORY_SCOPE_AGENT); }
__device__ __forceinline__ unsigned xb_add(unsigned* p, unsigned v) { return __hip_atomic_fetch_add(p, v, __ATOMIC_RELAXED, __HIP_MEMORY_SCOPE_AGENT); }
__device__ __forceinline__ unsigned xb_xcc_id() { return (unsigned)__builtin_amdgcn_s_getreg((3 << 11) | 20) & 0xFu; }
#define XB_SPIN(cond, bar) do { unsigned _sp = 0; while (cond) { __builtin_amdgcn_s_sleep(1); \
    if ((++_sp & 255u) == 0u) { if (xb_ld(&(bar)[XB_TMO])) break; if (_sp > XB_SPIN_CAP) { atomicAdd(&(bar)[XB_TMO], 1u); break; } } } } while (0)

struct XcdBarrier {
    unsigned* bar; unsigned x;
    volatile LAS unsigned* st;
};

__device__ __forceinline__ XcdBarrier xcd_barrier_post(unsigned* bar, volatile LAS unsigned* st) {
    XcdBarrier b; b.bar = bar; b.x = xb_xcc_id(); b.st = st;
    if (threadIdx.x == 0) (void)xb_add(&bar[XB_XCNT(b.x)], 1u);
    return b;
}
__device__ __forceinline__ void xcd_barrier_complete(unsigned* bar, unsigned x, unsigned& nloc, unsigned& nx) {
    const unsigned G = gridDim.x * gridDim.y * gridDim.z;
    unsigned sum, cnt, mine, sp = 0u;
    for (;;) {
        sum = 0u; cnt = 0u; mine = 0u;
#pragma unroll
        for (unsigned j = 0; j < 16; ++j) { const unsigned c = xb_ld(&bar[XB_XCNT(j)]); sum += c; cnt += (c > 0u) ? 1u : 0u; mine = (j == x) ? c : mine; }
        if (sum == G) break;
        __builtin_amdgcn_s_sleep(1);
        if ((++sp & 255u) == 0u) { if (xb_ld(&bar[XB_TMO])) break; if (sp > XB_SPIN_CAP) { atomicAdd(&bar[XB_TMO], 1u); break; } }
    }
    nloc = mine > 0u ? mine : 1u; nx = cnt > 0u ? cnt : 1u;
}

__device__ __forceinline__ void xcd_barrier(const XcdBarrier& b) {
    asm volatile("s_waitcnt vmcnt(0)" ::: "memory");
    __syncthreads();
    if (threadIdx.x == 0) {
        unsigned* bar = b.bar;
        __builtin_amdgcn_s_waitcnt(0);
        unsigned nloc = b.st[0], nx = b.st[1];
        if (nloc == 0u) { xcd_barrier_complete(bar, b.x, nloc, nx); b.st[0] = nloc; b.st[1] = nx; }
        const unsigned old = xb_add(&bar[XB_XSUB(b.x)], 1u);
        const unsigned gen = old / nloc;
        if (old + 1u == (gen + 1u) * nloc) {
            __builtin_amdgcn_fence(__ATOMIC_RELEASE, "agent");
            asm volatile("s_waitcnt vmcnt(0)" ::: "memory");
            const unsigned og = xb_add(&bar[XB_TOP], 1u);
            const unsigned tg = og / nx;
            if (og + 1u == (tg + 1u) * nx) xb_add(&bar[XB_TOPGEN], 1u);
            else XB_SPIN(xb_ld(&bar[XB_TOPGEN]) == tg, bar);
            __builtin_amdgcn_fence(__ATOMIC_ACQUIRE, "agent");
            xb_add(&bar[XB_XGEN(b.x)], 1u);
            asm volatile("s_waitcnt vmcnt(0)" ::: "memory");
        } else {
            XB_SPIN(xb_ld(&bar[XB_XGEN(b.x)]) == gen, bar);
            __builtin_amdgcn_fence(__ATOMIC_ACQUIRE, "agent");
            asm volatile("s_waitcnt vmcnt(0)" ::: "memory");
        }
    }
    __syncthreads();
}
#ifndef GEMM_MASK
#define GEMM_MASK 15
#endif
#ifndef REP_GEMM
#define REP_GEMM 1
#endif
#ifndef REP_MIX
#define REP_MIX 1
#endif
#ifndef REP_P0
#define REP_P0 1
#endif
#ifndef REP_NORM
#define REP_NORM 1
#endif
#ifndef REP_SYNC
#define REP_SYNC 1
#endif
#ifndef REP_SMALL
#define REP_SMALL 1
#endif

namespace mk {
using pg8::bf16_t; using pg8::bf16x8; using pg8::f32x4; using pg8::u32x4;
typedef unsigned u32x2 __attribute__((ext_vector_type(2)));

constexpr int D = 1024, NB = 8, SEQ = 2048, DEPTH = 2, NS = 128;
constexpr int MP = NB * SEQ;
constexpr int MT = MP + NS;
constexpr int INW = 2048, FF = 2816, NMOD = 6 * D, MODROWS = 144;
constexpr float RMS_EPS = 1e-6f, LN_EPS = 1e-5f;
constexpr int LDS_BYTES = 132096;

constexpr size_t O_Y = 0;
constexpr size_t O_NAP = (size_t)MT * D;
constexpr size_t O_NBP = O_NAP + (size_t)DEPTH * NB * 30 * 256;
constexpr size_t O_NDP = O_NBP + (size_t)DEPTH * NB * 15 * 256;
constexpr size_t O_NAS = O_NDP + (size_t)DEPTH * NB * 2 * 256;
constexpr size_t O_NBS = O_NAS + (size_t)DEPTH * NS * 30 * 256;
constexpr size_t O_NDS = O_NBS + (size_t)DEPTH * NS * 15 * 256;
constexpr size_t O_NVS = O_NDS + (size_t)DEPTH * NS * 2 * 256;
constexpr size_t O_END = O_NVS + (size_t)DEPTH * NS * 256;

constexpr size_t MiB = 1u << 20;
constexpr size_t WS_WIN = 1 * MiB, WS_WOUT = 9 * MiB, WS_WGU = 13 * MiB, WS_WDN = 35 * MiB, WS_MOD = 46 * MiB, WS_SC = 53 * MiB;
constexpr size_t WS_H = 54 * MiB, WS_PROJ = 87 * MiB, WS_MIX = 152 * MiB, WS_G = 87 * MiB, WS_MF = 185 * MiB, WS_WADA = 185 * MiB, WS_END = 250 * MiB;
static_assert(WS_WIN + 2ull * INW * D * 2 <= WS_WOUT && WS_WOUT + 2ull * D * D * 2 <= WS_WGU && WS_WGU + 2ull * 2 * FF * D * 2 <= WS_WDN && WS_WDN + 2ull * D * FF * 2 <= WS_MOD, "ws map 1");
static_assert(WS_MOD + 2ull * MODROWS * NMOD * 4 <= WS_SC && WS_SC + (size_t)MODROWS * D * 2 <= WS_H && WS_H + (size_t)MT * D * 2 <= WS_PROJ, "ws map 2");
static_assert(WS_PROJ + (size_t)MT * INW * 2 <= WS_MIX && WS_MIX + (size_t)MT * D * 2 <= WS_MF && WS_G + (size_t)MT * FF * 2 <= WS_MF && WS_MF + (size_t)MT * D * 4 <= WS_END && WS_WADA + 2ull * NMOD * D * 2 <= WS_END, "ws map 3");

struct Params {
    const float* in[29];
    float* out;
    unsigned char* ws;
    int ph_lo, ph_hi, coop, pad;
};
enum { I_XP = 0, I_XS, I_CP, I_CS, I_SA, I_SB, I_SD, I_WADA, I_BADA, I_GPREMIX, I_GPOSTMIX, I_WIN, I_CAW, I_CAB, I_LNAG, I_LNAB, I_POOLW, I_POOLS, I_LNCG, I_LNCB,
       I_SGUW, I_SGUB, I_CDW, I_WOUT, I_GPREFFN, I_GPOSTFFN, I_WGATE, I_WUP, I_WDOWN };

__device__ __forceinline__ int otid() { int t = threadIdx.x; asm volatile("" : "+v"(t)); return t; }
#define LDS_WAIT() asm volatile("s_waitcnt lgkmcnt(0)" ::: "memory")

__device__ __forceinline__ float bf2f(unsigned short h) { return __uint_as_float((unsigned)h << 16); }
__device__ __forceinline__ float bflo(unsigned w) { return __uint_as_float(w << 16); }
__device__ __forceinline__ float bfhi(unsigned w) { return __uint_as_float(w & 0xffff0000u); }
__device__ __forceinline__ unsigned pk2(float lo, float hi) { return pg8::cvt_pk_bf16(lo, hi); }
__device__ __forceinline__ unsigned short f2bf(float f) { return (unsigned short)(pk2(f, 0.f) & 0xffffu); }
__device__ __forceinline__ float sigmoid_(float x) { return __builtin_amdgcn_rcpf(1.f + __expf(-x)); }
__device__ __forceinline__ float silu_(float x) { return x * sigmoid_(x); }
__device__ __forceinline__ float wave_sum(float v) {
#pragma unroll
    for (int o = 1; o < 64; o <<= 1) v += __shfl_xor(v, o);
    return v;
}
__device__ __forceinline__ float sum4(f32x4 v) { return (v.x + v.y) + (v.z + v.w); }
__device__ __forceinline__ float dot4(f32x4 v) { return (v.x * v.x + v.y * v.y) + (v.z * v.z + v.w * v.w); }

struct EpiStoreBf16 {
    static constexpr bool PERM = true, AFTER_DRAIN = false;
    bf16_t* O; int ldc;
    __device__ __forceinline__ void operator()(const f32x4 (&acc)[2][2][4][2], const pg8::Unit& u, int wr, int wc, int fr, int fq) const {
        const int row0 = u.pm * 256 + wr * 64 + fr, col0 = u.pn * 256 + wc * 32 + 8 * fq;
#pragma unroll
        for (int ai = 0; ai < 2; ++ai)
#pragma unroll
            for (int m = 0; m < 4; ++m) { bf16_t* rowp = O + (size_t)(row0 + ai * 128 + m * 16) * ldc + col0;
#pragma unroll
                for (int bj = 0; bj < 2; ++bj) { const f32x4 v0 = acc[ai][bj][m][0], v1 = acc[ai][bj][m][1];
                    u32x4 w; w.x = pk2(v0[0], v0[1]); w.y = pk2(v0[2], v0[3]); w.z = pk2(v1[0], v1[1]); w.w = pk2(v1[2], v1[3]);
                    *(u32x4*)(rowp + bj * 128) = w; } }
    }
};
struct EpiStoreF32 {
    static constexpr bool PERM = false, AFTER_DRAIN = false;
    float* O; int ldc;
    __device__ __forceinline__ void operator()(const f32x4 (&acc)[2][2][4][2], const pg8::Unit& u, int wr, int wc, int fr, int fq) const {
        const int row0 = u.pm * 256 + wr * 64 + fr, col0 = u.pn * 256 + wc * 32 + 4 * fq;
#pragma unroll
        for (int ai = 0; ai < 2; ++ai)
#pragma unroll
            for (int m = 0; m < 4; ++m) { float* rowp = O + (size_t)(row0 + ai * 128 + m * 16) * ldc + col0;
#pragma unroll
                for (int bj = 0; bj < 2; ++bj)
#pragma unroll
                    for (int n = 0; n < 2; ++n) *(f32x4*)(rowp + bj * 128 + n * 16) = acc[ai][bj][m][n]; }
    }
};
struct EpiSwiGLU {
    static constexpr bool PERM = true, AFTER_DRAIN = false;
    bf16_t* O;
    __device__ __forceinline__ void operator()(const f32x4 (&acc)[2][2][4][2], const pg8::Unit& u, int wr, int wc, int fr, int fq) const {
        const int row0 = u.pm * 256 + wr * 64 + fr, col0 = u.pn * 128 + wc * 32 + 8 * fq;
#pragma unroll
        for (int ai = 0; ai < 2; ++ai)
#pragma unroll
            for (int m = 0; m < 4; ++m) { bf16_t* rowp = O + (size_t)(row0 + ai * 128 + m * 16) * FF + col0;
                const f32x4 g0 = acc[ai][0][m][0], g1 = acc[ai][0][m][1], u0 = acc[ai][1][m][0], u1 = acc[ai][1][m][1];
                u32x4 w; w.x = pk2(silu_(g0[0]) * u0[0], silu_(g0[1]) * u0[1]); w.y = pk2(silu_(g0[2]) * u0[2], silu_(g0[3]) * u0[3]);
                w.z = pk2(silu_(g1[0]) * u1[0], silu_(g1[1]) * u1[1]); w.w = pk2(silu_(g1[2]) * u1[2], silu_(g1[3]) * u1[3]);
                *(u32x4*)rowp = w; }
    }
};

template <int NMT, int MODE>
__device__ __forceinline__ void small_gemm_item(unsigned char* lds, const bf16_t* A, const bf16_t* B0, const bf16_t* B1, int K, void* out, int ldc, int col0, const float* bias) {
    const int tid = otid(), wid = tid >> 6, lane = tid & 63, fr = lane & 15, fq = lane >> 4;
    const int ksteps = K / 256;
    const int kbeg = wid * ksteps * 32 + 8 * fq;
    constexpr int NACC = NMT * (MODE == 2 ? 2 : 1);
    f32x4 acc[NACC];
#pragma unroll
    for (int i = 0; i < NACC; ++i) acc[i] = (f32x4){0.f, 0.f, 0.f, 0.f};
    const bf16_t* ap = A + (size_t)fr * K + kbeg;
    const bf16_t* bp0 = B0 + (size_t)fr * K + kbeg;
    const bf16_t* bp1 = (MODE == 2) ? B1 + (size_t)fr * K + kbeg : bp0;
    for (int ks = 0; ks < ksteps; ++ks) {
        const bf16x8 b0 = *(const bf16x8*)(bp0 + 32 * ks);
        bf16x8 b1 = b0; if (MODE == 2) b1 = *(const bf16x8*)(bp1 + 32 * ks);
#pragma unroll
        for (int mt = 0; mt < NMT; ++mt) {
            const bf16x8 a = *(const bf16x8*)(ap + (size_t)mt * 16 * K + 32 * ks);
            acc[mt] = __builtin_amdgcn_mfma_f32_16x16x32_bf16(b0, a, acc[mt], 0, 0, 0);
            if (MODE == 2) acc[NMT + mt] = __builtin_amdgcn_mfma_f32_16x16x32_bf16(b1, a, acc[NMT + mt], 0, 0, 0);
        }
    }
    f32x4* red = (f32x4*)lds;
#pragma unroll
    for (int i = 0; i < NACC; ++i) red[(wid * NACC + i) * 64 + lane] = acc[i];
    __syncthreads();
    for (int mt = wid; mt < NMT; mt += 8) {
        f32x4 s = (f32x4){0.f, 0.f, 0.f, 0.f}, s2 = (f32x4){0.f, 0.f, 0.f, 0.f};
#pragma unroll
        for (int w = 0; w < 8; ++w) { s += red[(w * NACC + mt) * 64 + lane]; if (MODE == 2) s2 += red[(w * NACC + NMT + mt) * 64 + lane]; }
        const int row = 16 * mt + fr, col = col0 + 4 * fq;
        if (MODE == 0) { u32x2 w; w.x = pk2(s[0], s[1]); w.y = pk2(s[2], s[3]); *(u32x2*)((bf16_t*)out + (size_t)row * ldc + col) = w; }
        else if (MODE == 1) { if (bias) s += *(const f32x4*)(bias + col); *(f32x4*)((float*)out + (size_t)row * ldc + col) = s; }
        else { u32x2 w; w.x = pk2(silu_(s[0]) * s2[0], silu_(s[1]) * s2[1]); w.y = pk2(silu_(s[2]) * s2[2], silu_(s[3]) * s2[3]); *(u32x2*)((bf16_t*)out + (size_t)row * ldc + col) = w; }
    }
    __syncthreads();
}

__device__ __forceinline__ void transpose_item(const float* W, int N, bf16_t* WT, int K, int k0, int n0, int drow0, float* scr, int lane) {
#pragma unroll 8
    for (int i = 0; i < 32; ++i) { const int kk = 2 * i + (lane >> 5); scr[kk * 33 + (lane & 31)] = W[(size_t)(k0 + kk) * N + n0 + (lane & 31)]; }
    LDS_WAIT();
    const int c = lane & 7;
#pragma unroll
    for (int j = 0; j < 4; ++j) { const int n = (lane >> 3) + 8 * j; const float* s = scr + (8 * c) * 33 + n;
        u32x4 o; o.x = pk2(s[0 * 33], s[1 * 33]); o.y = pk2(s[2 * 33], s[3 * 33]); o.z = pk2(s[4 * 33], s[5 * 33]); o.w = pk2(s[6 * 33], s[7 * 33]);
        *(u32x4*)(WT + (size_t)(drow0 + n) * K + k0 + 8 * c) = o; }
    LDS_WAIT();
}
constexpr int IT_WIN = 16 * 64, IT_WOUT = 16 * 32, IT_WG = 16 * 88, IT_WDN = 44 * 32, IT_WADA = 16 * 192;
constexpr int IT_LAYER = IT_WIN + IT_WOUT + 2 * IT_WG + IT_WDN + IT_WADA;
__device__ __forceinline__ void p0_prologue(const Params& P, unsigned char* lds) {
    const int tid = otid(), wid = tid >> 6, lane = tid & 63;
    float* scr = (float*)(lds + wid * 8448);
    const int gw = blockIdx.x * 8 + wid, NGW = gridDim.x * 8;
    unsigned char* ws = P.ws;
    for (int it = gw; it < DEPTH * IT_LAYER; it += NGW) {
        const int l = it / IT_LAYER; int r = it % IT_LAYER;
        if (r < IT_WIN) { const int kb = r / 64, nb = r % 64; transpose_item(P.in[I_WIN] + (size_t)l * D * INW, INW, (bf16_t*)(ws + WS_WIN) + (size_t)l * INW * D, D, 64 * kb, 32 * nb, 32 * nb, scr, lane); continue; }
        r -= IT_WIN;
        if (r < IT_WOUT) { const int kb = r / 32, nb = r % 32; transpose_item(P.in[I_WOUT] + (size_t)l * D * D, D, (bf16_t*)(ws + WS_WOUT) + (size_t)l * D * D, D, 64 * kb, 32 * nb, 32 * nb, scr, lane); continue; }
        r -= IT_WOUT;
        if (r < 2 * IT_WG) { const int up = r >= IT_WG; if (up) r -= IT_WG; const int kb = r / 88, nb = r % 88, n0 = 32 * nb;
            transpose_item((up ? P.in[I_WUP] : P.in[I_WGATE]) + (size_t)l * D * FF, FF, (bf16_t*)(ws + WS_WGU) + (size_t)l * 2 * FF * D, D, 64 * kb, n0, 256 * (n0 >> 7) + (n0 & 127) + (up ? 128 : 0), scr, lane); continue; }
        r -= 2 * IT_WG;
        if (r < IT_WDN) { const int kb = r / 32, nb = r % 32; transpose_item(P.in[I_WDOWN] + (size_t)l * FF * D, D, (bf16_t*)(ws + WS_WDN) + (size_t)l * D * FF, FF, 64 * kb, 32 * nb, 32 * nb, scr, lane); continue; }
        r -= IT_WDN;
        { const int kb = r / 192, nb = r % 192; transpose_item(P.in[I_WADA] + (size_t)l * D * NMOD, NMOD, (bf16_t*)(ws + WS_WADA) + (size_t)l * NMOD * D, D, 64 * kb, 32 * nb, 32 * nb, scr, lane); }
    }
    bf16_t* SC = (bf16_t*)(ws + WS_SC);
    for (int row = gw; row < MODROWS; row += NGW) {
        const float* c = row < NB ? P.in[I_CP] + (size_t)row * D : (row < NB + NS ? P.in[I_CS] + (size_t)(row - NB) * D : nullptr);
#pragma unroll
        for (int j = 0; j < 4; ++j) { f32x4 v = (f32x4){0.f, 0.f, 0.f, 0.f}; if (c) v = *(const f32x4*)(c + 256 * j + 4 * lane);
            u32x2 w; w.x = pk2(c ? silu_(v.x) : 0.f, c ? silu_(v.y) : 0.f); w.y = pk2(c ? silu_(v.z) : 0.f, c ? silu_(v.w) : 0.f);
            *(u32x2*)(SC + (size_t)row * D + 256 * j + 4 * lane) = w; }
    }
}

__device__ __forceinline__ void norm_phase(const Params& P, int kind, int l, bool dry = false) {
    const int tid = otid(), wid = tid >> 6, lane = tid & 63;
    const int gw = blockIdx.x * 8 + wid, NGW = gridDim.x * 8;
    const float* MOD = (const float*)(P.ws + WS_MOD);
    const float* MF = (const float*)(P.ws + WS_MF);
    bf16_t* H = (bf16_t*)(P.ws + WS_H);
    float* X = P.out + O_Y;
    for (int row = gw; row < MT; row += NGW) {
        const int mrow = row < MP ? row / SEQ : NB + (row - MP);
        const float* modp = MOD + ((size_t)l * MODROWS + mrow) * NMOD;
        const float* xin = (l == 0 && kind <= 1) ? (row < MP ? P.in[I_XP] + (size_t)row * D : P.in[I_XS] + (size_t)(row - MP) * D) : X + (size_t)row * D;
        f32x4 xv[4];
#pragma unroll
        for (int j = 0; j < 4; ++j) xv[j] = *(const f32x4*)(xin + 256 * j + 4 * lane);
        if (kind >= 1) {
            f32x4 mv[4]; float ss = 0.f;
#pragma unroll
            for (int j = 0; j < 4; ++j) { mv[j] = *(const f32x4*)(MF + (size_t)row * D + 256 * j + 4 * lane); ss += dot4(mv[j]); }
            const float rs = rsqrtf(wave_sum(ss) * (1.f / D) + RMS_EPS);
            const float* gp = (kind == 1 ? P.in[I_GPOSTMIX] : P.in[I_GPOSTFFN]) + (size_t)l * D;
            const float* gt = modp + (kind == 1 ? 2 * D : 5 * D);
#pragma unroll
            for (int j = 0; j < 4; ++j) { const f32x4 g = *(const f32x4*)(gp + 256 * j + 4 * lane), t = *(const f32x4*)(gt + 256 * j + 4 * lane);
                xv[j] = xv[j] + t * (mv[j] * rs * g);
                if (!dry) *(f32x4*)(X + (size_t)row * D + 256 * j + 4 * lane) = xv[j]; }
        }
        if (kind != 2 || l + 1 < DEPTH) {
            float ss = 0.f;
#pragma unroll
            for (int j = 0; j < 4; ++j) ss += dot4(xv[j]);
            const float rs = rsqrtf(wave_sum(ss) * (1.f / D) + RMS_EPS);
            const float* gp; const float* sc; const float* sh;
            if (kind == 0) { gp = P.in[I_GPREMIX] + (size_t)l * D; sh = modp; sc = modp + D; }
            else if (kind == 1) { gp = P.in[I_GPREFFN] + (size_t)l * D; sh = modp + 3 * D; sc = modp + 4 * D; }
            else { gp = P.in[I_GPREMIX] + (size_t)(l + 1) * D; sh = modp + (size_t)MODROWS * NMOD; sc = sh + D; }
#pragma unroll
            for (int j = 0; j < 4; ++j) { const f32x4 g = *(const f32x4*)(gp + 256 * j + 4 * lane), a = *(const f32x4*)(sc + 256 * j + 4 * lane), b = *(const f32x4*)(sh + 256 * j + 4 * lane);
                const f32x4 h = (xv[j] * rs * g) * (a + 1.f) + b;
                u32x2 w; w.x = pk2(h.x, h.y); w.y = pk2(h.z, h.w);
                if (!dry) *(u32x2*)(H + (size_t)row * D + 256 * j + 4 * lane) = w; else if (w.x == 0x12345678u && w.y == 0x9abcdef0u) *(u32x2*)(H + (size_t)row * D + 256 * j + 4 * lane) = w; }
        }
    }
}

__device__ __forceinline__ void mix_prompt_item(const Params& P, int l, int b, int rb, unsigned char* lds) {
    const int tid = otid(), wid = tid >> 6, lane = tid & 63, fr = lane & 15, fq = lane >> 4;
    const int t0 = 64 * rb; const size_t R0 = (size_t)b * SEQ + t0;
    const bf16_t* PR = (const bf16_t*)(P.ws + WS_PROJ);
    bf16_t* MX = (bf16_t*)(P.ws + WS_MIX);
    float* out = P.out;
    {
        float* ZA = (float*)lds;
        for (int i = wid; i < 94; i += 8) {
            const int t = t0 - 30 + i; f32x4 z = (f32x4){0.f, 0.f, 0.f, 0.f};
            if (t >= 0) { const bf16_t* p = PR + ((size_t)b * SEQ + t) * INW + 4 * lane; const u32x2 av = *(const u32x2*)p, ag = *(const u32x2*)(p + 256);
                z.x = bflo(av.x) * sigmoid_(bflo(ag.x)); z.y = bfhi(av.x) * sigmoid_(bfhi(ag.x)); z.z = bflo(av.y) * sigmoid_(bflo(ag.y)); z.w = bfhi(av.y) * sigmoid_(bfhi(ag.y)); }
            *(f32x4*)(ZA + i * 256 + 4 * lane) = z;
        }
        __syncthreads();
        if (rb == 31) { float* o = out + O_NAP + ((size_t)(l * NB + b) * 30) * 256; for (int idx = tid; idx < 30 * 256; idx += 512) o[idx] = ZA[64 * 256 + idx]; }
        const int c = tid & 255, half = tid >> 8;
        float w[31], acc[32];
        const float* cw = P.in[I_CAW] + (size_t)l * 31 * 256 + c;
#pragma unroll
        for (int k = 0; k < 31; ++k) w[k] = cw[k * 256];
        const float bias = P.in[I_CAB][l * 256 + c];
#pragma unroll
        for (int r = 0; r < 32; ++r) acc[r] = bias;
        const float* zp = ZA + (32 * half) * 256 + c;
#pragma unroll
        for (int i = 0; i < 62; ++i) { const float z = zp[i * 256];
#pragma unroll
            for (int r = 0; r < 32; ++r) { const int k = i - r; if (k >= 0 && k <= 30) acc[r] = fmaf(w[k], z, acc[r]); } }
        __syncthreads();
        float* Y = (float*)lds;
#pragma unroll
        for (int r = 0; r < 32; ++r) Y[(32 * half + r) * 256 + c] = acc[r];
        __syncthreads();
        const f32x4 g = *(const f32x4*)(P.in[I_LNAG] + l * 256 + 4 * lane), bb = *(const f32x4*)(P.in[I_LNAB] + l * 256 + 4 * lane);
        for (int r = wid; r < 64; r += 8) {
            const f32x4 v = *(const f32x4*)(Y + r * 256 + 4 * lane);
            const float mean = wave_sum(sum4(v)) * (1.f / 256.f); const f32x4 d = v - mean;
            const float rstd = rsqrtf(wave_sum(dot4(d)) * (1.f / 256.f) + LN_EPS);
            const f32x4 y = d * rstd * g + bb;
            u32x2 o; o.x = pk2(silu_(y.x), silu_(y.y)); o.y = pk2(silu_(y.z), silu_(y.w));
            *(u32x2*)(MX + (R0 + r) * D + 4 * lane) = o;
        }
        __syncthreads();
    }
    {
        float* ZB = (float*)lds;
        bf16_t* DB = (bf16_t*)(lds + 80896);
        for (int i = wid; i < 79; i += 8) {
            const int t = t0 - 15 + i; f32x4 z = (f32x4){0.f, 0.f, 0.f, 0.f};
            if (t >= 0) { const u32x2 v = *(const u32x2*)(PR + ((size_t)b * SEQ + t) * INW + 512 + 4 * lane); z.x = bflo(v.x); z.y = bfhi(v.x); z.z = bflo(v.y); z.w = bfhi(v.y); }
            *(f32x4*)(ZB + i * 256 + 4 * lane) = z;
        }
        __syncthreads();
        if (rb == 31) { float* o = out + O_NBP + ((size_t)(l * NB + b) * 15) * 256; for (int idx = tid; idx < 15 * 256; idx += 512) o[idx] = ZB[64 * 256 + idx]; }
        {
            const int c = tid & 255, half = tid >> 8, w = 2 << (c >> 6), r0 = 32 * half;
            float sum = 0.f;
            for (int k = 1; k < w; ++k) sum += ZB[(r0 + 15 - k) * 256 + c];
            for (int r = 0; r < 32; ++r) {
                const float z = ZB[(r0 + r + 15) * 256 + c];
                sum += z;
                const int t = t0 + r0 + r; const int cnt = (t + 1 < w) ? t + 1 : w;
                const float d = sum * __builtin_amdgcn_rcpf((float)cnt) - z;
                DB[(r0 + r) * 264 + c] = f2bf(d);
                sum -= ZB[(r0 + r + 16 - w) * 256 + c];
            }
        }
        __syncthreads();
        {
            const int g = wid & 3, th = wid >> 2;
            const float* pw = P.in[I_POOLW] + ((size_t)(l * 4 + g) * 64) * 64;
            bf16x8 wf[4][2];
#pragma unroll
            for (int nt = 0; nt < 4; ++nt)
#pragma unroll
                for (int ks = 0; ks < 2; ++ks) { const float* q = pw + (size_t)(32 * ks + 8 * fq) * 64 + 16 * nt + fr;
                    u32x4 t; t.x = pk2(q[0], q[64]); t.y = pk2(q[128], q[192]); t.z = pk2(q[256], q[320]); t.w = pk2(q[384], q[448]);
                    wf[nt][ks] = __builtin_bit_cast(bf16x8, t); }
            f32x4 acc[2][4];
#pragma unroll
            for (int tt = 0; tt < 2; ++tt)
#pragma unroll
                for (int nt = 0; nt < 4; ++nt) acc[tt][nt] = (f32x4){0.f, 0.f, 0.f, 0.f};
#pragma unroll
            for (int tt = 0; tt < 2; ++tt)
#pragma unroll
                for (int ks = 0; ks < 2; ++ks) { const bf16x8 df = *(const bf16x8*)(DB + (32 * th + 16 * tt + fr) * 264 + 64 * g + 32 * ks + 8 * fq);
#pragma unroll
                    for (int nt = 0; nt < 4; ++nt) acc[tt][nt] = __builtin_amdgcn_mfma_f32_16x16x32_bf16(wf[nt][ks], df, acc[tt][nt], 0, 0, 0); }
#pragma unroll
            for (int tt = 0; tt < 2; ++tt)
#pragma unroll
                for (int nt = 0; nt < 4; ++nt) { const f32x4 sc = *(const f32x4*)(P.in[I_POOLS] + l * 256 + 64 * g + 16 * nt + 4 * fq); const f32x4 o = acc[tt][nt] * sc;
                    u32x2 w; w.x = pk2(o.x, o.y); w.y = pk2(o.z, o.w);
                    *(u32x2*)(MX + (R0 + 32 * th + 16 * tt + fr) * D + 256 + 64 * g + 16 * nt + 4 * fq) = w; }
        }
        __syncthreads();
    }
    {
        const int c2 = tid & 127, q = tid >> 7;
        const float* cw = P.in[I_CDW] + (size_t)l * 3 * 256 + 2 * c2;
        const float w0a = cw[0], w0b = cw[1], w1a = cw[256], w1b = cw[257], w2a = cw[512], w2b = cw[513];
        float zm2a = 0.f, zm2b = 0.f, zm1a = 0.f, zm1b = 0.f;
        for (int rr = -2; rr < 16; ++rr) {
            const int t = t0 + 16 * q + rr; float z0 = 0.f, z1 = 0.f; unsigned dbv = 0u;
            if (t >= 0) { const bf16_t* p = PR + ((size_t)b * SEQ + t) * INW + 2 * c2; const unsigned dc = *(const unsigned*)(p + 1536), dh = *(const unsigned*)(p + 1792);
                z0 = bflo(dc) * bflo(dh); z1 = bfhi(dc) * bfhi(dh); if (rr >= 0) dbv = *(const unsigned*)(p + 1280); }
            if (rr >= 0) {
                const float y0 = bflo(dbv) * (w0a * zm2a + w1a * zm1a + w2a * z0), y1 = bfhi(dbv) * (w0b * zm2b + w1b * zm1b + w2b * z1);
                *(unsigned*)(MX + (R0 + 16 * q + rr) * D + 768 + 2 * c2) = pk2(y0, y1);
                if (t >= SEQ - 2) { float* o = out + O_NDP + ((size_t)(l * NB + b) * 2 + (t - (SEQ - 2))) * 256 + 2 * c2; o[0] = z0; o[1] = z1; }
            }
            zm2a = zm1a; zm2b = zm1b; zm1a = z0; zm1b = z1;
        }
    }
    {
        const int n = rb >> 1, hf = rb & 1, nrows = 64 * (hf + 1);
        const size_t C0 = (size_t)b * SEQ + 128 * n;
        bf16_t* VT = (bf16_t*)lds;
        const float* lg = P.in[I_LNCG] + l * 256; const float* lb = P.in[I_LNCB] + l * 256;
        const float g0 = lg[lane], g1 = lg[lane + 64], g2 = lg[lane + 128], g3 = lg[lane + 192], b0 = lb[lane], b1 = lb[lane + 64], b2 = lb[lane + 128], b3 = lb[lane + 192];
        for (int j = wid; j < nrows; j += 8) {
            const bf16_t* p = PR + (C0 + j) * INW + 1024 + lane;
            const float v0 = bf2f(p[0]), v1 = bf2f(p[64]), v2 = bf2f(p[128]), v3 = bf2f(p[192]);
            const float mean = wave_sum((v0 + v1) + (v2 + v3)) * (1.f / 256.f);
            const float d0 = v0 - mean, d1 = v1 - mean, d2 = v2 - mean, d3 = v3 - mean;
            const float rstd = rsqrtf(wave_sum((d0 * d0 + d1 * d1) + (d2 * d2 + d3 * d3)) * (1.f / 256.f) + LN_EPS);
            VT[(lane) * 136 + j] = f2bf(d0 * rstd * g0 + b0); VT[(lane + 64) * 136 + j] = f2bf(d1 * rstd * g1 + b1);
            VT[(lane + 128) * 136 + j] = f2bf(d2 * rstd * g2 + b2); VT[(lane + 192) * 136 + j] = f2bf(d3 * rstd * g3 + b3);
        }
        __syncthreads();
        const int h = wid & 3, I0 = 64 * hf + 32 * (wid >> 2);
        const float* W = P.in[I_SGUW] + ((size_t)(l * 4 + h) * 128) * 128;
        f32x4 acc[2][4];
#pragma unroll
        for (int it = 0; it < 2; ++it)
#pragma unroll
            for (int nt = 0; nt < 4; ++nt) acc[it][nt] = (f32x4){0.f, 0.f, 0.f, 0.f};
#pragma unroll
        for (int it = 0; it < 2; ++it) {
            const int i0 = I0 + 16 * it, i = i0 + fr, nks = (i0 >> 5) + 1;
            for (int ks = 0; ks < nks; ++ks) {
                const int j0 = 32 * ks + 8 * fq;
                f32x4 wa = *(const f32x4*)(W + (size_t)i * 128 + j0), wb = *(const f32x4*)(W + (size_t)i * 128 + j0 + 4);
                wa.x = (j0 + 0 <= i) ? wa.x : 0.f; wa.y = (j0 + 1 <= i) ? wa.y : 0.f; wa.z = (j0 + 2 <= i) ? wa.z : 0.f; wa.w = (j0 + 3 <= i) ? wa.w : 0.f;
                wb.x = (j0 + 4 <= i) ? wb.x : 0.f; wb.y = (j0 + 5 <= i) ? wb.y : 0.f; wb.z = (j0 + 6 <= i) ? wb.z : 0.f; wb.w = (j0 + 7 <= i) ? wb.w : 0.f;
                u32x4 t; t.x = pk2(wa.x, wa.y); t.y = pk2(wa.z, wa.w); t.z = pk2(wb.x, wb.y); t.w = pk2(wb.z, wb.w);
                const bf16x8 wfrag = __builtin_bit_cast(bf16x8, t);
#pragma unroll
                for (int nt = 0; nt < 4; ++nt) { const bf16x8 vf = *(const bf16x8*)(VT + (64 * h + 16 * nt + fr) * 136 + j0);
                    acc[it][nt] = __builtin_amdgcn_mfma_f32_16x16x32_bf16(vf, wfrag, acc[it][nt], 0, 0, 0); }
            }
        }
#pragma unroll
        for (int it = 0; it < 2; ++it) {
            const int i = I0 + 16 * it + fr; const float bs = P.in[I_SGUB][(l * 4 + h) * 128 + i]; const size_t row = C0 + i;
#pragma unroll
            for (int nt = 0; nt < 4; ++nt) { const int cc = 64 * h + 16 * nt + 4 * fq; const u32x2 cu = *(const u32x2*)(PR + row * INW + 768 + cc);
                const f32x4 a = acc[it][nt] + bs;
                u32x2 o; o.x = pk2(bflo(cu.x) * a.x, bfhi(cu.x) * a.y); o.y = pk2(bflo(cu.y) * a.z, bfhi(cu.y) * a.w);
                *(u32x2*)(MX + row * D + 512 + cc) = o; }
        }
        __syncthreads();
    }
}

__device__ __forceinline__ void mix_sample_item(const Params& P, int l, int pair, unsigned char* lds) {
    const int tid = otid(), wid = tid >> 6, lane = tid & 63, c = tid & 255, hs = tid >> 8, s = 2 * pair + hs;
    const bf16_t* PR = (const bf16_t*)(P.ws + WS_PROJ);
    bf16_t* MX = (bf16_t*)(P.ws + WS_MIX);
    float* out = P.out;
    const size_t row = (size_t)MP + s;
    const bf16_t* p = PR + row * INW + c;
    const float av = bf2f(p[0]), ag = bf2f(p[256]), bi = bf2f(p[512]), cu = bf2f(p[768]), cv = bf2f(p[1024]), db = bf2f(p[1280]), dc = bf2f(p[1536]), dh = bf2f(p[1792]);
    const float za = av * sigmoid_(ag);
    const float* sa = P.in[I_SA] + ((size_t)(l * NS + s) * 30) * 256 + c;
    float* na = out + O_NAS + ((size_t)(l * NS + s) * 30) * 256 + c;
    const float* caw = P.in[I_CAW] + (size_t)l * 31 * 256 + c;
    float ya = P.in[I_CAB][l * 256 + c];
    for (int k = 0; k < 30; ++k) { const float z = sa[k * 256]; ya = fmaf(caw[k * 256], z, ya); if (k >= 1) na[(k - 1) * 256] = z; }
    ya = fmaf(caw[30 * 256], za, ya); na[29 * 256] = za;
    const int g = c >> 6, w = 2 << g;
    const float* sb = P.in[I_SB] + ((size_t)(l * NS + s) * 15) * 256 + c;
    float* nb = out + O_NBS + ((size_t)(l * NS + s) * 15) * 256 + c;
    float sum = bi;
    for (int k = 0; k < 15; ++k) { const float z = sb[k * 256]; if (k >= 16 - w) sum += z; if (k >= 1) nb[(k - 1) * 256] = z; }
    nb[14 * 256] = bi;
    const float dpool = sum * (1.f / (float)w) - bi;
    const float zd = dc * dh;
    const float* sd = P.in[I_SD] + ((size_t)(l * NS + s) * 2) * 256 + c;
    float* nd = out + O_NDS + ((size_t)(l * NS + s) * 2) * 256 + c;
    const float s0 = sd[0], s1 = sd[256];
    const float* cdw = P.in[I_CDW] + (size_t)l * 3 * 256 + c;
    const float yd = db * (cdw[0] * s0 + cdw[256] * s1 + cdw[512] * zd);
    nd[0] = s1; nd[256] = zd;
    const float r0 = wave_sum(ya), r1 = wave_sum(cv);
    float* RED = (float*)lds;
    float* DL = RED + 64;
    if (lane == 0) { RED[wid * 4 + 0] = r0; RED[wid * 4 + 1] = r1; }
    DL[hs * 256 + c] = dpool;
    __syncthreads();
    const int wb = hs * 16;
    const float meanA = ((RED[wb + 0] + RED[wb + 4]) + (RED[wb + 8] + RED[wb + 12])) * (1.f / 256.f);
    const float meanC = ((RED[wb + 1] + RED[wb + 5]) + (RED[wb + 9] + RED[wb + 13])) * (1.f / 256.f);
    const float da = ya - meanA, dcv = cv - meanC;
    const float q0 = wave_sum(da * da), q1 = wave_sum(dcv * dcv);
    if (lane == 0) { RED[wid * 4 + 2] = q0; RED[wid * 4 + 3] = q1; }
    __syncthreads();
    const float rstdA = rsqrtf(((RED[wb + 2] + RED[wb + 6]) + (RED[wb + 10] + RED[wb + 14])) * (1.f / 256.f) + LN_EPS);
    const float rstdC = rsqrtf(((RED[wb + 3] + RED[wb + 7]) + (RED[wb + 11] + RED[wb + 15])) * (1.f / 256.f) + LN_EPS);
    const float yA = silu_(da * rstdA * P.in[I_LNAG][l * 256 + c] + P.in[I_LNAB][l * 256 + c]);
    const float vn = dcv * rstdC * P.in[I_LNCG][l * 256 + c] + P.in[I_LNCB][l * 256 + c];
    out[O_NVS + (size_t)(l * NS + s) * 256 + c] = vn;
    const float yc = cu * (P.in[I_SGUW][((size_t)(l * 4 + g) * 128) * 128] * vn + P.in[I_SGUB][(l * 4 + g) * 128]);
    const float* pw = P.in[I_POOLW] + ((size_t)(l * 4 + g) * 64) * 64 + (c & 63);
    float yb = 0.f;
    for (int cc = 0; cc < 64; ++cc) yb = fmaf(DL[hs * 256 + 64 * g + cc], pw[cc * 64], yb);
    yb *= P.in[I_POOLS][l * 256 + c];
    MX[row * D + c] = f2bf(yA); MX[row * D + 256 + c] = f2bf(yb); MX[row * D + 512 + c] = f2bf(yc); MX[row * D + 768 + c] = f2bf(yd);
    __syncthreads();
}

__global__ void __launch_bounds__(512, 2) mk_fwd(Params P) {
    extern __shared__ __attribute__((aligned(16))) unsigned char lds[];
    const int G = gridDim.x, bx = blockIdx.x;
    unsigned char* ws = P.ws;
    bf16_t* const H = (bf16_t*)(ws + WS_H); bf16_t* const PROJ = (bf16_t*)(ws + WS_PROJ); bf16_t* const MIX = (bf16_t*)(ws + WS_MIX); bf16_t* const GB = (bf16_t*)(ws + WS_G);
    float* const MF = (float*)(ws + WS_MF);
    PG8_LAS unsigned char* ring = (PG8_LAS unsigned char*)lds;
    int ph = 0;
    if (P.pad == 0x7fffffff) cg::this_grid().sync();
    { volatile LAS unsigned* st = (volatile LAS unsigned*)(ring + 131072); if (threadIdx.x < 2) st[threadIdx.x] = 0u; __syncthreads(); }
    XcdBarrier xbar; xbar.bar = (unsigned*)ws; xbar.x = 0; xbar.st = nullptr;
    if (P.coop) xbar = xcd_barrier_post((unsigned*)ws, (volatile LAS unsigned*)(ring + 131072));
#define IN_PH() (P.ph_lo <= ph && ph < P.ph_hi)
#define SEAM() do { if (P.coop && P.ph_lo <= ph && ph + 1 < P.ph_hi) for (int rep_ = 0; rep_ < REP_SYNC; ++rep_) xcd_barrier(xbar); ++ph; } while (0)
    #ifndef NO_P0
    if (IN_PH()) for (int rep = 0; rep < REP_P0; ++rep) p0_prologue(P, lds);
#endif
    SEAM();
    if (IN_PH()) {

#ifndef NO_MOD
        for (int it = bx; it < DEPTH * (NMOD / 16); it += G) { const int l = it / (NMOD / 16), nt = it % (NMOD / 16);
            small_gemm_item<9, 1>(lds, (const bf16_t*)(ws + WS_SC), (const bf16_t*)(ws + WS_WADA) + ((size_t)l * NMOD + 16 * nt) * D, nullptr, D,
                                  (float*)(ws + WS_MOD) + (size_t)l * MODROWS * NMOD, NMOD, 16 * nt, P.in[I_BADA] + (size_t)l * NMOD); }
#endif

    }
    SEAM();
    for (int l = 0; l < DEPTH; ++l) {
        const bf16_t* WIN = (const bf16_t*)(ws + WS_WIN) + (size_t)l * INW * D; const bf16_t* WOUT = (const bf16_t*)(ws + WS_WOUT) + (size_t)l * D * D;
        const bf16_t* WGU = (const bf16_t*)(ws + WS_WGU) + (size_t)l * 2 * FF * D; const bf16_t* WDN = (const bf16_t*)(ws + WS_WDN) + (size_t)l * D * FF;
        if (l == 0) {
#ifndef NO_NORM
 if (IN_PH()) { for (int rep = 1; rep < REP_NORM; ++rep) norm_phase(P, 0, 0, true); norm_phase(P, 0, 0); }
#endif
 SEAM(); }
        if (IN_PH()) {
            pg8::Gemm g{H, WIN, MP, INW, D}; pg8::StaticOrder S; S.init(MP, INW, G, bx); EpiStoreBf16 E{PROJ, INW};
#if !defined(NO_GEMM) && (GEMM_MASK & 1)
            for (int rep = 0; rep < REP_GEMM; ++rep) pg8::gemm_phase<EpiStoreBf16, pg8::StaticOrder, true, true>(ring, g, S, E);
#endif
#ifndef NO_SMALL
            for (int rep = 0; rep < REP_SMALL; ++rep) for (int it = bx; it < INW / 16; it += G) small_gemm_item<8, 0>(lds, H + (size_t)MP * D, WIN + (size_t)16 * it * D, nullptr, D, PROJ + (size_t)MP * INW, INW, 16 * it, nullptr);
#endif
        }
        SEAM();
        if (IN_PH()) {
            for (int rep = 0; rep < REP_MIX; ++rep) for (int it = bx; it < NB * 32 + NS / 2; it += G) {
#ifndef NO_MIXP
 if (it < NB * 32) mix_prompt_item(P, l, it >> 5, it & 31, lds);
#endif
#ifndef NO_MIXS
 if (it >= NB * 32) mix_sample_item(P, l, it - NB * 32, lds);
#endif
 }
        }
        SEAM();
        if (IN_PH()) {
            pg8::Gemm g{MIX, WOUT, MP, D, D}; pg8::StaticOrder S; S.init(MP, D, G, bx); EpiStoreF32 E{MF, D};
#if !defined(NO_GEMM) && (GEMM_MASK & 2)
            for (int rep = 0; rep < REP_GEMM; ++rep) pg8::gemm_phase<EpiStoreF32, pg8::StaticOrder, true, true>(ring, g, S, E);
#endif
#ifndef NO_SMALL
            for (int rep = 0; rep < REP_SMALL; ++rep) for (int it = bx; it < D / 16; it += G) small_gemm_item<8, 1>(lds, MIX + (size_t)MP * D, WOUT + (size_t)16 * it * D, nullptr, D, MF + (size_t)MP * D, D, 16 * it, nullptr);
#endif
        }
        SEAM();
#ifndef NO_NORM
        if (IN_PH()) { for (int rep = 1; rep < REP_NORM; ++rep) norm_phase(P, 1, l, true); norm_phase(P, 1, l); }
#endif
        SEAM();
        if (IN_PH()) {
            pg8::Gemm g{H, WGU, MP, 2 * FF, D}; pg8::StaticOrder S; S.init(MP, 2 * FF, G, bx); EpiSwiGLU E{GB};
#if !defined(NO_GEMM) && (GEMM_MASK & 4)
            for (int rep = 0; rep < REP_GEMM; ++rep) pg8::gemm_phase<EpiSwiGLU, pg8::StaticOrder, true, true>(ring, g, S, E);
#endif
#ifndef NO_SMALL
            for (int rep = 0; rep < REP_SMALL; ++rep) for (int it = (bx + G / 2) % G; it < FF / 16; it += G) { const int ff0 = 16 * it; const bf16_t* b0 = WGU + (size_t)(256 * (ff0 >> 7) + (ff0 & 127)) * D;
                small_gemm_item<8, 2>(lds, H + (size_t)MP * D, b0, b0 + (size_t)128 * D, D, GB + (size_t)MP * FF, FF, ff0, nullptr); }
#endif
        }
        SEAM();
        if (IN_PH()) {
            pg8::Gemm g{GB, WDN, MP, D, FF}; pg8::StaticOrder S; S.init(MP, D, G, bx); EpiStoreF32 E{MF, D};
#if !defined(NO_GEMM) && (GEMM_MASK & 8)
            for (int rep = 0; rep < REP_GEMM; ++rep) pg8::gemm_phase<EpiStoreF32, pg8::StaticOrder, true, true>(ring, g, S, E);
#endif
#ifndef NO_SMALL
            for (int rep = 0; rep < REP_SMALL; ++rep) for (int it = bx; it < D / 16; it += G) small_gemm_item<8, 1>(lds, GB + (size_t)MP * FF, WDN + (size_t)16 * it * FF, nullptr, FF, MF + (size_t)MP * D, D, 16 * it, nullptr);
#endif
        }
        SEAM();
#ifndef NO_NORM
        if (IN_PH()) { for (int rep = 1; rep < REP_NORM; ++rep) norm_phase(P, 2, l, true); norm_phase(P, 2, l); }
#endif
        SEAM();
    }
#undef IN_PH
#undef SEAM
}
constexpr int N_PHASES = 2 + 1 + 7 * DEPTH;
}

#ifndef GEMM_MASK
#define GEMM_MASK 15
#endif
#ifndef MK_MULTI
#define MK_MULTI 0
#endif
extern "C" void kernel_launch(void* const* d_in, const int* in_sizes, int n_in, void* d_out, int out_size, void* d_ws, size_t ws_size, hipStream_t stream) {
    using namespace mk;
    static int grid = 0;
    if (grid == 0) {
        if (n_in != 29 || (size_t)out_size != O_END || ws_size < WS_END) { fprintf(stderr, "kernel_launch: unexpected shapes: n_in %d out %d ws %zu\n", n_in, out_size, ws_size); grid = -1; return; }
        int dev = 0, cus = 0, per_cu = 0;
        hipGetDevice(&dev); hipDeviceGetAttribute(&cus, hipDeviceAttributeMultiprocessorCount, dev);
        if (hipFuncSetAttribute((const void*)mk_fwd, hipFuncAttributeMaxDynamicSharedMemorySize, LDS_BYTES) != hipSuccess) { fprintf(stderr, "kernel_launch: hipFuncSetAttribute failed\n"); grid = -1; return; }
        if (hipOccupancyMaxActiveBlocksPerMultiprocessor(&per_cu, (const void*)mk_fwd, 512, LDS_BYTES) != hipSuccess || per_cu < 1) { fprintf(stderr, "kernel_launch: occupancy query says %d\n", per_cu); per_cu = 1; }
        (void)hipGetLastError();
        grid = cus * per_cu;
        fprintf(stderr, "kernel_launch: grid %d (cus %d x %d)\n", grid, cus, per_cu);
    }
    if (grid < 0) return;
    if (hipMemsetAsync(d_ws, 0, 65536, stream) != hipSuccess) { fprintf(stderr, "kernel_launch: memset failed\n"); return; }
    Params p{};
    for (int i = 0; i < 29; ++i) p.in[i] = (const float*)d_in[i];
    p.out = (float*)d_out; p.ws = (unsigned char*)d_ws;
#if MK_MULTI
    for (int ph = 0; ph < N_PHASES; ++ph) { p.ph_lo = ph; p.ph_hi = ph + 1; p.coop = 0; hipLaunchKernelGGL(mk_fwd, dim3(grid), dim3(512), LDS_BYTES, stream, p); }
#else
    p.ph_lo = 0; p.ph_hi = N_PHASES; p.coop = 1;
    void* args[] = {&p};
    hipError_t e = hipLaunchCooperativeKernel((void*)mk_fwd, dim3(grid), dim3(512), args, LDS_BYTES, stream);
    if (e != hipSuccess) fprintf(stderr, "kernel_launch: cooperative launch failed: %s (grid %d)\n", hipGetErrorString(e), grid);
#endif
}
```

```cpp
#include <hip/hip_runtime.h>
#include <hip/hip_cooperative_groups.h>
#include <cstdio>
#include <cstdint>
namespace cg = cooperative_groups;
namespace pg8 {
#define PG8_LAS __attribute__((address_space(3)))
typedef unsigned short bf16_t;
typedef short bf16x8 __attribute__((ext_vector_type(8)));
typedef float f32x4 __attribute__((ext_vector_type(4)));
typedef unsigned u32x4 __attribute__((ext_vector_type(4)));
constexpr int BM = 256, BK = 64, HALF = 128, HTB = HALF * BK * 2  , STAGE_BYTES = 8 * HTB, NXCD = 8, WGM = 8;

__host__ __device__ __forceinline__ int lds_byte(int r, int c) { const int st = (r >> 4) * 2 + (c >> 5), rr = r & 15, cc = c & 31, ob = rr * 64 + cc * 2; return st * 1024 + (ob ^ (((ob >> 9) & 1) << 5)); }
__host__ __device__ __forceinline__ void stage_rc(int b, int& R, int& C) { const int st = b / 1024, sb = b % 1024, swz = sb ^ (((sb >> 9) & 1) << 5); R = (st >> 1) * 16 + swz / 64; C = (st & 1) * 32 + (swz % 64) / 2; }
__host__ __device__ __forceinline__ int perm32(int rho) { const int n = rho >> 4, i = rho & 15; return 8 * (i >> 2) + 4 * n + (i & 3); }

struct Unit { int pm, pn; };
struct Gemm { const bf16_t* A; const bf16_t* Bt; int M, N, K; };

struct StaticOrder {
    int nM, nN, nwg, G, c;
    __host__ __device__ void init(int M, int N, int G_, int c_) { nM = M / BM; nN = N / BM; nwg = nM * nN; G = G_; c = c_; }
    __host__ __device__ bool next(int i, Unit& u) const {
        const long L = (long)i * G + c; if (L >= nwg) return false;
        int wgid = (int)L; { const int q = nwg / NXCD, r = nwg % NXCD, xcd = wgid % NXCD, off = wgid / NXCD; wgid = (xcd < r ? xcd * (q + 1) : r * (q + 1) + (xcd - r) * q) + off; }
        const int nig = WGM * nN, gid = wgid / nig, fm = gid * WGM, gsz = (nM - fm) < WGM ? (nM - fm) : WGM;
        u.pm = fm + ((wgid % nig) % gsz); u.pn = (wgid % nig) / gsz; return true;
    }
    __device__ __forceinline__ void a_ready(const Unit&) const {}
    __device__ __forceinline__ void done(const Unit&) const {}
};
__device__ __forceinline__ unsigned cvt_pk_bf16(float lo, float hi) { unsigned r; asm volatile("v_cvt_pk_bf16_f32 %0, %1, %2" : "=v"(r) : "v"(lo), "v"(hi)); return r; }
template <class Epi, class Sched, bool ALIGN_EPI = false, bool SP2 = false>
__device__ __forceinline__ void gemm_phase(PG8_LAS unsigned char* lds, const Gemm g, const Sched& S, const Epi& E) {
    int tid_ = threadIdx.x; asm volatile("" : "+v"(tid_)); const int tid = tid_, wid = __builtin_amdgcn_readfirstlane(tid >> 6), lane = tid & 63, wr = wid >> 2, wc = wid & 3, fr = lane & 15, fq = lane >> 4;
    const int K = g.K, nt = K / BK;
    unsigned voffA[2], voffB[2];
#pragma unroll
    for (int i = 0; i < 2; ++i) { int R, C; stage_rc(tid * 16 + i * 8192, R, C); const int Rb = Epi::PERM ? ((R & ~31) + perm32(R & 31)) : R;
        voffA[i] = (unsigned)(R * K + C) * 2u; voffB[i] = (unsigned)(Rb * K + C) * 2u; }
    const size_t kstep = (size_t)(BK * 2);
    const size_t hstep = (size_t)HALF * K * 2;
    const size_t tstep = 2 * hstep;
    const unsigned ldsw = (unsigned)wid * 1024u;
    const int aoff = lds_byte(wr * 64 + fr, fq * 8), boff = lds_byte(wc * 32 + fr, fq * 8);
#define PG8_SA(b, h) (((b) * 2 + (h)) * HTB)
#define PG8_SB(b, h) ((4 + (b) * 2 + (h)) * HTB)
#define PG8_STAGE(bufoff, gbase, voff) do { _Pragma("unroll") for (int _i = 0; _i < 2; ++_i) \
        __builtin_amdgcn_global_load_lds((const unsigned*)((const char*)(gbase) + (voff)[_i]), (PG8_LAS unsigned*)(lds + (bufoff) + ldsw + _i * 8192), 16, 0, 0); } while (0)
#define PG8_LDA(dst, b, h) do { _Pragma("unroll") for (int m = 0; m < 4; ++m) _Pragma("unroll") for (int k = 0; k < 2; ++k) dst[m][k] = *(const PG8_LAS bf16x8*)(lds + PG8_SA(b, h) + aoff + m * 2048 + k * 1024); } while (0)
#define PG8_LDB(dst, b, h) do { _Pragma("unroll") for (int n = 0; n < 2; ++n) _Pragma("unroll") for (int k = 0; k < 2; ++k) dst[n][k] = *(const PG8_LAS bf16x8*)(lds + PG8_SB(b, h) + boff + n * 2048 + k * 1024); } while (0)
#define PG8_MMA(ai, bj, At, Bt) do { __builtin_amdgcn_s_setprio(1); _Pragma("unroll") for (int m = 0; m < 4; ++m) _Pragma("unroll") for (int n = 0; n < 2; ++n) _Pragma("unroll") for (int k = 0; k < 2; ++k) \
        acc[ai][bj][m][n] = __builtin_amdgcn_mfma_f32_16x16x32_bf16(Bt[n][k], At[m][k], acc[ai][bj][m][n], 0, 0, 0); __builtin_amdgcn_s_setprio(0); } while (0)
#define PG8_WAIT_V(n) asm volatile("s_waitcnt vmcnt(" #n ")" ::: "memory")
#define PG8_WAIT_L(n) asm volatile("s_waitcnt lgkmcnt(" #n ")" ::: "memory")
#define PG8_BAR __builtin_amdgcn_s_barrier()
#define PG8_SCHED __builtin_amdgcn_sched_barrier(0)
    Unit cur, nxt; int ui = 0;
    if (!S.next(0, cur)) return;
    f32x4 acc[2][2][4][2];
#pragma unroll
    for (int a = 0; a < 2; ++a)
#pragma unroll
        for (int b = 0; b < 2; ++b)
#pragma unroll
            for (int m = 0; m < 4; ++m)
#pragma unroll
                for (int n = 0; n < 2; ++n) acc[a][b][m][n] = (f32x4){0.f, 0.f, 0.f, 0.f};
    bf16x8 At[4][2], B0[2][2], B1[2][2];
    const char* cA = (const char*)g.A + (size_t)cur.pm * tstep; const char* cB = (const char*)g.Bt + (size_t)cur.pn * tstep;
    S.a_ready(cur);
    if constexpr (SP2) {
        PG8_STAGE(PG8_SB(0, 0), cB, voffB); PG8_STAGE(PG8_SB(0, 1), cB + hstep, voffB); PG8_STAGE(PG8_SA(0, 0), cA, voffA); PG8_STAGE(PG8_SA(0, 1), cA + hstep, voffA);
        if (wr == 1) PG8_BAR;
        PG8_WAIT_V(2); PG8_BAR;
        PG8_STAGE(PG8_SB(1, 0), cB + kstep, voffB); PG8_STAGE(PG8_SA(1, 0), cA + kstep, voffA); PG8_STAGE(PG8_SB(1, 1), cB + hstep + kstep, voffB);
        PG8_WAIT_V(6); PG8_BAR;
    } else {
        PG8_STAGE(PG8_SB(0, 0), cB, voffB); PG8_STAGE(PG8_SA(0, 0), cA, voffA); PG8_STAGE(PG8_SB(0, 1), cB + hstep, voffB); PG8_STAGE(PG8_SA(0, 1), cA + hstep, voffA);
        if (wr == 1) PG8_BAR;
        PG8_WAIT_V(4); PG8_BAR;
        PG8_STAGE(PG8_SB(1, 0), cB + kstep, voffB); PG8_STAGE(PG8_SA(1, 0), cA + kstep, voffA); PG8_STAGE(PG8_SB(1, 1), cB + hstep + kstep, voffB);
        PG8_WAIT_V(6); PG8_BAR;
    }
    for (;;) {
        const bool has_next = S.next(ui + 1, nxt);
        const char* nA = has_next ? (const char*)g.A + (size_t)nxt.pm * tstep : cA; const char* nB = has_next ? (const char*)g.Bt + (size_t)nxt.pn * tstep : cB;
        for (int t = 0; t < nt; t += 2) {
            const bool last = (t == nt - 2);
            const char* a1 = cA + (size_t)(t + 1) * kstep;
            const char* a2 = last ? nA : cA + (size_t)(t + 2) * kstep; const char* b2 = last ? nB : cB + (size_t)(t + 2) * kstep;
            const char* a3 = a2 + kstep; const char* b3 = b2 + kstep;
            if (last && has_next) S.a_ready(nxt);
            if constexpr (SP2) {
            PG8_LDB(B0, 0, 0); PG8_LDB(B1, 0, 1); PG8_SCHED; PG8_LDA(At, 0, 0); PG8_STAGE(PG8_SA(1, 1), a1 + hstep, voffA);
            PG8_WAIT_V(8); PG8_WAIT_L(0); PG8_BAR; PG8_MMA(0, 0, At, B0); PG8_MMA(0, 1, At, B1); PG8_BAR; PG8_SCHED;
            PG8_LDA(At, 0, 1); PG8_STAGE(PG8_SB(0, 0), b2, voffB); PG8_STAGE(PG8_SB(0, 1), b2 + hstep, voffB); PG8_STAGE(PG8_SA(0, 0), a2, voffA);
            PG8_WAIT_V(8); PG8_WAIT_L(0); PG8_BAR; PG8_MMA(1, 0, At, B0); PG8_MMA(1, 1, At, B1); PG8_BAR; PG8_SCHED;
            PG8_LDB(B0, 1, 0); PG8_LDB(B1, 1, 1); PG8_SCHED; PG8_LDA(At, 1, 0); PG8_STAGE(PG8_SA(0, 1), a2 + hstep, voffA);
            PG8_WAIT_V(8); PG8_WAIT_L(0); PG8_BAR; PG8_MMA(0, 0, At, B0); PG8_MMA(0, 1, At, B1); PG8_BAR; PG8_SCHED;
            PG8_LDA(At, 1, 1); PG8_STAGE(PG8_SB(1, 0), b3, voffB); PG8_STAGE(PG8_SB(1, 1), b3 + hstep, voffB); PG8_STAGE(PG8_SA(1, 0), a3, voffA);
            PG8_WAIT_V(8); PG8_WAIT_L(0); PG8_BAR; PG8_MMA(1, 0, At, B0); PG8_MMA(1, 1, At, B1); PG8_BAR; PG8_SCHED;
            } else {
            PG8_LDB(B0, 0, 0); PG8_SCHED; PG8_LDA(At, 0, 0); PG8_STAGE(PG8_SA(1, 1), a1 + hstep, voffA);
            PG8_WAIT_L(8); PG8_BAR; PG8_WAIT_L(0); PG8_MMA(0, 0, At, B0); PG8_BAR; PG8_SCHED;
            PG8_LDB(B1, 0, 1); PG8_STAGE(PG8_SB(0, 0), b2, voffB);
            PG8_BAR; PG8_WAIT_L(0); PG8_MMA(0, 1, At, B1); PG8_BAR;
            PG8_LDA(At, 0, 1); PG8_STAGE(PG8_SA(0, 0), a2, voffA);
            PG8_BAR; PG8_WAIT_L(0); PG8_MMA(1, 0, At, B0); PG8_BAR; PG8_SCHED;
            PG8_STAGE(PG8_SB(0, 1), b2 + hstep, voffB);
            PG8_WAIT_V(6); PG8_BAR; PG8_MMA(1, 1, At, B1); PG8_BAR;
            PG8_LDB(B0, 1, 0); PG8_SCHED; PG8_LDA(At, 1, 0); PG8_STAGE(PG8_SA(0, 1), a2 + hstep, voffA);
            PG8_WAIT_L(8); PG8_BAR; PG8_WAIT_L(0); PG8_MMA(0, 0, At, B0); PG8_BAR; PG8_SCHED;
            PG8_LDB(B1, 1, 1); PG8_STAGE(PG8_SB(1, 0), b3, voffB);
            PG8_BAR; PG8_WAIT_L(0); PG8_MMA(0, 1, At, B1); PG8_BAR;
            PG8_LDA(At, 1, 1); PG8_STAGE(PG8_SA(1, 0), a3, voffA);
            PG8_BAR; PG8_WAIT_L(0); PG8_MMA(1, 0, At, B0); PG8_BAR; PG8_SCHED;
            PG8_STAGE(PG8_SB(1, 1), b3 + hstep, voffB);
            PG8_WAIT_V(6); PG8_BAR; PG8_MMA(1, 1, At, B1); PG8_BAR;
            }
        }
        if constexpr (ALIGN_EPI) { if (wr == 0) PG8_BAR; }
        if constexpr (!Epi::AFTER_DRAIN) { E(acc, cur, wr, wc, fr, fq); S.done(cur); }
        if (!has_next) break;
#pragma unroll
        for (int a = 0; a < 2; ++a)
#pragma unroll
            for (int b = 0; b < 2; ++b)
#pragma unroll
                for (int m = 0; m < 4; ++m)
#pragma unroll
                    for (int n = 0; n < 2; ++n) acc[a][b][m][n] = (f32x4){0.f, 0.f, 0.f, 0.f};
        cur = nxt; cA = nA; cB = nB; ++ui;
        if constexpr (ALIGN_EPI) { if (wr == 1) PG8_BAR; }
    }
    PG8_WAIT_V(0);
    if constexpr (!ALIGN_EPI) { if (wr == 0) PG8_BAR; }
    PG8_BAR;
    if constexpr (Epi::AFTER_DRAIN) { E.fused(acc, cur, wr, wc, fr, fq, lds, wid, lane); S.done(cur); }
#undef PG8_SA
#undef PG8_SB
#undef PG8_STAGE
#undef PG8_LDA
#undef PG8_LDB
#undef PG8_MMA
#undef PG8_WAIT_V
#undef PG8_WAIT_L
#undef PG8_BAR
#undef PG8_SCHED
}
}
#define LAS __attribute__((address_space(3)))
#define XB_TMO      128
#define XB_XCNT(j)  (256  + 64 * (j))
#define XB_XSUB(j)  (1280 + 64 * (j))
#define XB_XGEN(j)  (2304 + 64 * (j))
#define XB_TOP      3328
#define XB_TOPGEN   3392
#define XCD_BAR_WORDS 3456
#define XB_SPIN_CAP (1u << 18)

__device__ __forceinline__ unsigned xb_ld(unsigned* p)              { return __hip_atomic_load(p, __ATOMIC_RELAXED, __HIP_MEMORY_SCOPE_AGENT); }
__device__ __forceinline__ unsigned xb_add(unsigned* p, unsigned v) { return __hip_atomic_fetch_add(p, v, __ATOMIC_RELAXED, __HIP_MEMORY_SCOPE_AGENT); }
__device__ __forceinline__ unsigned xb_xcc_id() { return (unsigned)__builtin_amdgcn_s_getreg((3 << 11) | 20) & 0xFu; }
#define XB_SPIN(cond, bar) do { unsigned _sp = 0; while (cond) { __builtin_amdgcn_s_sleep(1); \
    if ((++_sp & 255u) == 0u) { if (xb_ld(&(bar)[XB_TMO])) break; if (_sp > XB_SPIN_CAP) { atomicAdd(&(bar)[XB_TMO], 1u); break; } } } } while (0)

struct XcdBarrier {
    unsigned* bar; unsigned x;
    volatile LAS unsigned* st;
};

__device__ __forceinline__ XcdBarrier xcd_barrier_post(unsigned* bar, volatile LAS unsigned* st) {
    XcdBarrier b; b.bar = bar; b.x = xb_xcc_id(); b.st = st;
    if (threadIdx.x == 0) (void)xb_add(&bar[XB_XCNT(b.x)], 1u);
    return b;
}
__device__ __forceinline__ void xcd_barrier_complete(unsigned* bar, unsigned x, unsigned& nloc, unsigned& nx) {
    const unsigned G = gridDim.x * gridDim.y * gridDim.z;
    unsigned sum, cnt, mine, sp = 0u;
    for (;;) {
        sum = 0u; cnt = 0u; mine = 0u;
#pragma unroll
        for (unsigned j = 0; j < 16; ++j) { const unsigned c = xb_ld(&bar[XB_XCNT(j)]); sum += c; cnt += (c > 0u) ? 1u : 0u; mine = (j == x) ? c : mine; }
        if (sum == G) break;
        __builtin_amdgcn_s_sleep(1);
        if ((++sp & 255u) == 0u) { if (xb_ld(&bar[XB_TMO])) break; if (sp > XB_SPIN_CAP) { atomicAdd(&bar[XB_TMO], 1u); break; } }
    }
    nloc = mine > 0u ? mine : 1u; nx = cnt > 0u ? cnt : 1u;
}

__device__ __forceinline__ void xcd_barrier(const XcdBarrier& b) {
    asm volatile("s_waitcnt vmcnt(0)" ::: "memory");
    __syncthreads();
    if (threadIdx.x == 0) {
        unsigned* bar = b.bar;
        __builtin_amdgcn_s_waitcnt(0);
        unsigned nloc = b.st[0], nx = b.st[1];
        if (nloc == 0u) { xcd_barrier_complete(bar, b.x, nloc, nx); b.st[0] = nloc; b.st[1] = nx; }
        const unsigned old = xb_add(&bar[XB_XSUB(b.x)], 1u);
        const unsigned gen = old / nloc;
        if (old + 1u == (gen + 1u) * nloc) {
            __builtin_amdgcn_fence(__ATOMIC_RELEASE, "agent");
            asm volatile("s_waitcnt vmcnt(0)" ::: "memory");
            const unsigned og = xb_add(&bar[XB_TOP], 1u);
            const unsigned tg = og / nx;
            if (og + 1u == (tg + 1u) * nx) xb_add(&bar[XB_TOPGEN], 1u);
            else XB_SPIN(xb_ld(&bar[XB_TOPGEN]) == tg, bar);
            __builtin_amdgcn_fence(__ATOMIC_ACQUIRE, "agent");
            xb_add(&bar[XB_XGEN(b.x)], 1u);
            asm volatile("s_waitcnt vmcnt(0)" ::: "memory");
        } else {
            XB_SPIN(xb_ld(&bar[XB_XGEN(b.x)]) == gen, bar);
            __builtin_amdgcn_fence(__ATOMIC_ACQUIRE, "agent");
            asm volatile("s_waitcnt vmcnt(0)" ::: "memory");
        }
    }
    __syncthreads();
}
#ifndef MK_MULTI
#define MK_MULTI 0
#endif
#ifndef GEMM_MASK
#define GEMM_MASK 15
#endif
#ifndef REP_GEMM
#define REP_GEMM 1
#endif
#ifndef REP_MIX
#define REP_MIX 1
#endif
#ifndef REP_P0
#define REP_P0 1
#endif
#ifndef REP_NORM
#define REP_NORM 1
#endif
#ifndef REP_SYNC
#define REP_SYNC 1
#endif
#ifndef REP_SMALL
#define REP_SMALL 1
#endif

namespace mk {
using pg8::bf16_t; using pg8::bf16x8; using pg8::f32x4; using pg8::u32x4;
typedef unsigned u32x2 __attribute__((ext_vector_type(2)));

constexpr int D = 1024, NB = 8, SEQ = 2048, DEPTH = 2, NS = 128;
constexpr int MP = NB * SEQ;
constexpr int MT = MP + NS;
constexpr int INW = 2048, FF = 2816, NMOD = 6 * D, MODROWS = 144;
constexpr float RMS_EPS = 1e-6f, LN_EPS = 1e-5f;
constexpr int LDS_BYTES = 132096;

constexpr size_t O_Y = 0;
constexpr size_t O_NAP = (size_t)MT * D;
constexpr size_t O_NBP = O_NAP + (size_t)DEPTH * NB * 30 * 256;
constexpr size_t O_NDP = O_NBP + (size_t)DEPTH * NB * 15 * 256;
constexpr size_t O_NAS = O_NDP + (size_t)DEPTH * NB * 2 * 256;
constexpr size_t O_NBS = O_NAS + (size_t)DEPTH * NS * 30 * 256;
constexpr size_t O_NDS = O_NBS + (size_t)DEPTH * NS * 15 * 256;
constexpr size_t O_NVS = O_NDS + (size_t)DEPTH * NS * 2 * 256;
constexpr size_t O_END = O_NVS + (size_t)DEPTH * NS * 256;

constexpr size_t MiB = 1u << 20;
constexpr size_t WS_WIN = 1 * MiB, WS_WOUT = 9 * MiB, WS_WGU = 13 * MiB, WS_WDN = 35 * MiB, WS_MOD = 46 * MiB, WS_SC = 53 * MiB;
constexpr size_t WS_H = 54 * MiB, WS_PROJ = 87 * MiB, WS_MIX = 152 * MiB, WS_G = 87 * MiB, WS_MF = 185 * MiB, WS_WADA = 185 * MiB, WS_END = 250 * MiB;
static_assert(WS_WIN + 2ull * INW * D * 2 <= WS_WOUT && WS_WOUT + 2ull * D * D * 2 <= WS_WGU && WS_WGU + 2ull * 2 * FF * D * 2 <= WS_WDN && WS_WDN + 2ull * D * FF * 2 <= WS_MOD, "ws map 1");
static_assert(WS_MOD + 2ull * MODROWS * NMOD * 4 <= WS_SC && WS_SC + (size_t)MODROWS * D * 2 <= WS_H && WS_H + (size_t)MT * D * 2 <= WS_PROJ, "ws map 2");
static_assert(WS_PROJ + (size_t)MT * INW * 2 <= WS_MIX && WS_MIX + (size_t)MT * D * 2 <= WS_MF && WS_G + (size_t)MT * FF * 2 <= WS_MF && WS_MF + (size_t)MT * D * 4 <= WS_END && WS_WADA + 2ull * NMOD * D * 2 <= WS_END, "ws map 3");

struct Params {
    const float* in[29];
    float* out;
    unsigned char* ws;
    int ph_lo, ph_hi, coop, pad;
};
enum { I_XP = 0, I_XS, I_CP, I_CS, I_SA, I_SB, I_SD, I_WADA, I_BADA, I_GPREMIX, I_GPOSTMIX, I_WIN, I_CAW, I_CAB, I_LNAG, I_LNAB, I_POOLW, I_POOLS, I_LNCG, I_LNCB,
       I_SGUW, I_SGUB, I_CDW, I_WOUT, I_GPREFFN, I_GPOSTFFN, I_WGATE, I_WUP, I_WDOWN };

__device__ __forceinline__ int otid() { int t = threadIdx.x; asm volatile("" : "+v"(t)); return t; }
__device__ __forceinline__ int obx() { int t = blockIdx.x; asm volatile("" : "+s"(t)); return t; }
#define LDS_WAIT() asm volatile("s_waitcnt lgkmcnt(0)" ::: "memory")

__device__ __forceinline__ float bf2f(unsigned short h) { return __uint_as_float((unsigned)h << 16); }
__device__ __forceinline__ float bflo(unsigned w) { return __uint_as_float(w << 16); }
__device__ __forceinline__ float bfhi(unsigned w) { return __uint_as_float(w & 0xffff0000u); }
__device__ __forceinline__ unsigned pk2(float lo, float hi) { return pg8::cvt_pk_bf16(lo, hi); }
__device__ __forceinline__ unsigned short f2bf(float f) { return (unsigned short)(pk2(f, 0.f) & 0xffffu); }
__device__ __forceinline__ float sigmoid_(float x) { return __builtin_amdgcn_rcpf(1.f + __expf(-x)); }
__device__ __forceinline__ float silu_(float x) { return x * sigmoid_(x); }
template <int CTRL> __device__ __forceinline__ float dpp_(float v) { return __builtin_bit_cast(float, __builtin_amdgcn_update_dpp(0, __builtin_bit_cast(int, v), CTRL, 0xf, 0xf, true)); }
__device__ __forceinline__ float wave_sum(float v) {
    v += dpp_<0xB1>(v); v += dpp_<0x4E>(v); v += dpp_<0x141>(v); v += dpp_<0x140>(v);
    const int iv = __builtin_bit_cast(int, v);
    return (__builtin_bit_cast(float, __builtin_amdgcn_readlane(iv, 0)) + __builtin_bit_cast(float, __builtin_amdgcn_readlane(iv, 16))) +
           (__builtin_bit_cast(float, __builtin_amdgcn_readlane(iv, 32)) + __builtin_bit_cast(float, __builtin_amdgcn_readlane(iv, 48)));
}
__device__ __forceinline__ float sum4(f32x4 v) { return (v.x + v.y) + (v.z + v.w); }
__device__ __forceinline__ float dot4(f32x4 v) { return (v.x * v.x + v.y * v.y) + (v.z * v.z + v.w * v.w); }

struct EpiStoreBf16 {
    static constexpr bool PERM = true, AFTER_DRAIN = false;
    bf16_t* O; int ldc;
    __device__ __forceinline__ void operator()(const f32x4 (&acc)[2][2][4][2], const pg8::Unit& u, int wr, int wc, int fr, int fq) const {
        const int row0 = u.pm * 256 + wr * 64 + fr, col0 = u.pn * 256 + wc * 32 + 8 * fq;
#pragma unroll
        for (int ai = 0; ai < 2; ++ai)
#pragma unroll
            for (int m = 0; m < 4; ++m) { bf16_t* rowp = O + (size_t)(row0 + ai * 128 + m * 16) * ldc + col0;
#pragma unroll
                for (int bj = 0; bj < 2; ++bj) { const f32x4 v0 = acc[ai][bj][m][0], v1 = acc[ai][bj][m][1];
                    u32x4 w; w.x = pk2(v0[0], v0[1]); w.y = pk2(v0[2], v0[3]); w.z = pk2(v1[0], v1[1]); w.w = pk2(v1[2], v1[3]);
                    *(u32x4*)(rowp + bj * 128) = w; } }
    }
};
struct EpiStoreF32 {
    static constexpr bool PERM = false, AFTER_DRAIN = false;
    float* O; int ldc;
    __device__ __forceinline__ void operator()(const f32x4 (&acc)[2][2][4][2], const pg8::Unit& u, int wr, int wc, int fr, int fq) const {
        const int row0 = u.pm * 256 + wr * 64 + fr, col0 = u.pn * 256 + wc * 32 + 4 * fq;
#pragma unroll
        for (int ai = 0; ai < 2; ++ai)
#pragma unroll
            for (int m = 0; m < 4; ++m) { float* rowp = O + (size_t)(row0 + ai * 128 + m * 16) * ldc + col0;
#pragma unroll
                for (int bj = 0; bj < 2; ++bj)
#pragma unroll
                    for (int n = 0; n < 2; ++n) *(f32x4*)(rowp + bj * 128 + n * 16) = acc[ai][bj][m][n]; }
    }
};
struct EpiSwiGLU {
    static constexpr bool PERM = true, AFTER_DRAIN = false;
    bf16_t* O;
    __device__ __forceinline__ void operator()(const f32x4 (&acc)[2][2][4][2], const pg8::Unit& u, int wr, int wc, int fr, int fq) const {
        const int row0 = u.pm * 256 + wr * 64 + fr, col0 = u.pn * 128 + wc * 32 + 8 * fq;
#pragma unroll
        for (int ai = 0; ai < 2; ++ai)
#pragma unroll
            for (int m = 0; m < 4; ++m) { bf16_t* rowp = O + (size_t)(row0 + ai * 128 + m * 16) * FF + col0;
                const f32x4 g0 = acc[ai][0][m][0], g1 = acc[ai][0][m][1], u0 = acc[ai][1][m][0], u1 = acc[ai][1][m][1];
                u32x4 w; w.x = pk2(silu_(g0[0]) * u0[0], silu_(g0[1]) * u0[1]); w.y = pk2(silu_(g0[2]) * u0[2], silu_(g0[3]) * u0[3]);
                w.z = pk2(silu_(g1[0]) * u1[0], silu_(g1[1]) * u1[1]); w.w = pk2(silu_(g1[2]) * u1[2], silu_(g1[3]) * u1[3]);
                *(u32x4*)rowp = w; }
    }
};

template <int NMT, int MODE>
__device__ __forceinline__ void small_gemm_item(unsigned char* lds, const bf16_t* A, const bf16_t* B0, const bf16_t* B1, int K, void* out, int ldc, int col0, const float* bias) {
    const int tid = otid(), wid = tid >> 6, lane = tid & 63, fr = lane & 15, fq = lane >> 4;
    const int ksteps = K / 256;
    const int kbeg = wid * ksteps * 32 + 8 * fq;
    constexpr int NACC = NMT * (MODE == 2 ? 2 : 1);
    f32x4 acc[NACC];
#pragma unroll
    for (int i = 0; i < NACC; ++i) acc[i] = (f32x4){0.f, 0.f, 0.f, 0.f};
    const bf16_t* ap = A + (size_t)fr * K + kbeg;
    const bf16_t* bp0 = B0 + (size_t)fr * K + kbeg;
    const bf16_t* bp1 = (MODE == 2) ? B1 + (size_t)fr * K + kbeg : bp0;
    for (int ks = 0; ks < ksteps; ++ks) {
        const bf16x8 b0 = *(const bf16x8*)(bp0 + 32 * ks);
        bf16x8 b1 = b0; if (MODE == 2) b1 = *(const bf16x8*)(bp1 + 32 * ks);
#pragma unroll
        for (int mt = 0; mt < NMT; ++mt) {
            const bf16x8 a = *(const bf16x8*)(ap + (size_t)mt * 16 * K + 32 * ks);
            acc[mt] = __builtin_amdgcn_mfma_f32_16x16x32_bf16(b0, a, acc[mt], 0, 0, 0);
            if (MODE == 2) acc[NMT + mt] = __builtin_amdgcn_mfma_f32_16x16x32_bf16(b1, a, acc[NMT + mt], 0, 0, 0);
        }
    }
    f32x4* red = (f32x4*)lds;
#pragma unroll
    for (int i = 0; i < NACC; ++i) red[(wid * NACC + i) * 64 + lane] = acc[i];
    __syncthreads();
    for (int mt = wid; mt < NMT; mt += 8) {
        f32x4 s = (f32x4){0.f, 0.f, 0.f, 0.f}, s2 = (f32x4){0.f, 0.f, 0.f, 0.f};
#pragma unroll
        for (int w = 0; w < 8; ++w) { s += red[(w * NACC + mt) * 64 + lane]; if (MODE == 2) s2 += red[(w * NACC + NMT + mt) * 64 + lane]; }
        const int row = 16 * mt + fr, col = col0 + 4 * fq;
        if (MODE == 0) { u32x2 w; w.x = pk2(s[0], s[1]); w.y = pk2(s[2], s[3]); *(u32x2*)((bf16_t*)out + (size_t)row * ldc + col) = w; }
        else if (MODE == 1) { if (bias) s += *(const f32x4*)(bias + col); *(f32x4*)((float*)out + (size_t)row * ldc + col) = s; }
        else { u32x2 w; w.x = pk2(silu_(s[0]) * s2[0], silu_(s[1]) * s2[1]); w.y = pk2(silu_(s[2]) * s2[2], silu_(s[3]) * s2[3]); *(u32x2*)((bf16_t*)out + (size_t)row * ldc + col) = w; }
    }
    __syncthreads();
}

__device__ __forceinline__ void transpose_item(const float* W, int N, bf16_t* WT, int K, int k0, int n0, int drow0, float* scr, int lane) {
#pragma unroll 8
    for (int i = 0; i < 32; ++i) { const int kk = 2 * i + (lane >> 5); scr[kk * 33 + (lane & 31)] = W[(size_t)(k0 + kk) * N + n0 + (lane & 31)]; }
    LDS_WAIT();
    const int c = lane & 7;
#pragma unroll
    for (int j = 0; j < 4; ++j) { const int n = (lane >> 3) + 8 * j; const float* s = scr + (8 * c) * 33 + n;
        u32x4 o; o.x = pk2(s[0 * 33], s[1 * 33]); o.y = pk2(s[2 * 33], s[3 * 33]); o.z = pk2(s[4 * 33], s[5 * 33]); o.w = pk2(s[6 * 33], s[7 * 33]);
        *(u32x4*)(WT + (size_t)(drow0 + n) * K + k0 + 8 * c) = o; }
    LDS_WAIT();
}
constexpr int IT_WIN = 16 * 64, IT_WOUT = 16 * 32, IT_WG = 16 * 88, IT_WDN = 44 * 32, IT_WADA = 16 * 192;
constexpr int IT_LAYER = IT_WIN + IT_WOUT + 2 * IT_WG + IT_WDN + IT_WADA;
__device__ __forceinline__ void p0_prologue(const Params& P, unsigned char* lds) {
    const int tid = otid(), wid = tid >> 6, lane = tid & 63;
    float* scr = (float*)(lds + wid * 8448);
    const int gw = obx() * 8 + wid, NGW = gridDim.x * 8;
    unsigned char* ws = P.ws;
    for (int it = gw; it < DEPTH * IT_LAYER; it += NGW) {
        const int l = it / IT_LAYER; int r = it % IT_LAYER;
        if (r < IT_WIN) { const int kb = r / 64, nb = r % 64; transpose_item(P.in[I_WIN] + (size_t)l * D * INW, INW, (bf16_t*)(ws + WS_WIN) + (size_t)l * INW * D, D, 64 * kb, 32 * nb, 32 * nb, scr, lane); continue; }
        r -= IT_WIN;
        if (r < IT_WOUT) { const int kb = r / 32, nb = r % 32; transpose_item(P.in[I_WOUT] + (size_t)l * D * D, D, (bf16_t*)(ws + WS_WOUT) + (size_t)l * D * D, D, 64 * kb, 32 * nb, 32 * nb, scr, lane); continue; }
        r -= IT_WOUT;
        if (r < 2 * IT_WG) { const int up = r >= IT_WG; if (up) r -= IT_WG; const int kb = r / 88, nb = r % 88, n0 = 32 * nb;
            transpose_item((up ? P.in[I_WUP] : P.in[I_WGATE]) + (size_t)l * D * FF, FF, (bf16_t*)(ws + WS_WGU) + (size_t)l * 2 * FF * D, D, 64 * kb, n0, 256 * (n0 >> 7) + (n0 & 127) + (up ? 128 : 0), scr, lane); continue; }
        r -= 2 * IT_WG;
        if (r < IT_WDN) { const int kb = r / 32, nb = r % 32; transpose_item(P.in[I_WDOWN] + (size_t)l * FF * D, D, (bf16_t*)(ws + WS_WDN) + (size_t)l * D * FF, FF, 64 * kb, 32 * nb, 32 * nb, scr, lane); continue; }
        r -= IT_WDN;
        { const int kb = r / 192, nb = r % 192; transpose_item(P.in[I_WADA] + (size_t)l * D * NMOD, NMOD, (bf16_t*)(ws + WS_WADA) + (size_t)l * NMOD * D, D, 64 * kb, 32 * nb, 32 * nb, scr, lane); }
    }
    bf16_t* SC = (bf16_t*)(ws + WS_SC);
    for (int row = gw; row < MODROWS; row += NGW) {
        const float* c = row < NB ? P.in[I_CP] + (size_t)row * D : (row < NB + NS ? P.in[I_CS] + (size_t)(row - NB) * D : nullptr);
#pragma unroll
        for (int j = 0; j < 4; ++j) { f32x4 v = (f32x4){0.f, 0.f, 0.f, 0.f}; if (c) v = *(const f32x4*)(c + 256 * j + 4 * lane);
            u32x2 w; w.x = pk2(c ? silu_(v.x) : 0.f, c ? silu_(v.y) : 0.f); w.y = pk2(c ? silu_(v.z) : 0.f, c ? silu_(v.w) : 0.f);
            *(u32x2*)(SC + (size_t)row * D + 256 * j + 4 * lane) = w; }
    }
}

__device__ __forceinline__ void norm_phase(const Params& P, int kind, int l, bool dry = false) {
    const int tid = otid(), wid = tid >> 6, lane = tid & 63;
    const int gw = obx() * 8 + wid, NGW = gridDim.x * 8;
    const float* MOD = (const float*)(P.ws + WS_MOD);
    const float* MF = (const float*)(P.ws + WS_MF);
    bf16_t* H = (bf16_t*)(P.ws + WS_H);
    float* X = P.out + O_Y;
    for (int row = gw; row < MT; row += NGW) {
        const int mrow = row < MP ? row / SEQ : NB + (row - MP);
        const float* modp = MOD + ((size_t)l * MODROWS + mrow) * NMOD;
        const float* xin = (l == 0 && kind <= 1) ? (row < MP ? P.in[I_XP] + (size_t)row * D : P.in[I_XS] + (size_t)(row - MP) * D) : X + (size_t)row * D;
        f32x4 xv[4];
#pragma unroll
        for (int j = 0; j < 4; ++j) xv[j] = *(const f32x4*)(xin + 256 * j + 4 * lane);
        if (kind >= 1) {
            f32x4 mv[4]; float ss = 0.f;
#pragma unroll
            for (int j = 0; j < 4; ++j) { mv[j] = *(const f32x4*)(MF + (size_t)row * D + 256 * j + 4 * lane); ss += dot4(mv[j]); }
            const float rs = rsqrtf(wave_sum(ss) * (1.f / D) + RMS_EPS);
            const float* gp = (kind == 1 ? P.in[I_GPOSTMIX] : P.in[I_GPOSTFFN]) + (size_t)l * D;
            const float* gt = modp + (kind == 1 ? 2 * D : 5 * D);
#pragma unroll
            for (int j = 0; j < 4; ++j) { const f32x4 g = *(const f32x4*)(gp + 256 * j + 4 * lane), t = *(const f32x4*)(gt + 256 * j + 4 * lane);
                xv[j] = xv[j] + t * (mv[j] * rs * g);
                if (!dry) *(f32x4*)(X + (size_t)row * D + 256 * j + 4 * lane) = xv[j]; }
        }
        if (kind != 2 || l + 1 < DEPTH) {
            float ss = 0.f;
#pragma unroll
            for (int j = 0; j < 4; ++j) ss += dot4(xv[j]);
            const float rs = rsqrtf(wave_sum(ss) * (1.f / D) + RMS_EPS);
            const float* gp; const float* sc; const float* sh;
            if (kind == 0) { gp = P.in[I_GPREMIX] + (size_t)l * D; sh = modp; sc = modp + D; }
            else if (kind == 1) { gp = P.in[I_GPREFFN] + (size_t)l * D; sh = modp + 3 * D; sc = modp + 4 * D; }
            else { gp = P.in[I_GPREMIX] + (size_t)(l + 1) * D; sh = modp + (size_t)MODROWS * NMOD; sc = sh + D; }
#pragma unroll
            for (int j = 0; j < 4; ++j) { const f32x4 g = *(const f32x4*)(gp + 256 * j + 4 * lane), a = *(const f32x4*)(sc + 256 * j + 4 * lane), b = *(const f32x4*)(sh + 256 * j + 4 * lane);
                const f32x4 h = (xv[j] * rs * g) * (a + 1.f) + b;
                u32x2 w; w.x = pk2(h.x, h.y); w.y = pk2(h.z, h.w);
                if (!dry) *(u32x2*)(H + (size_t)row * D + 256 * j + 4 * lane) = w; else if (w.x == 0x12345678u && w.y == 0x9abcdef0u) *(u32x2*)(H + (size_t)row * D + 256 * j + 4 * lane) = w; }
        }
    }
}

template <int W>
__device__ __forceinline__ void pool_d(const float* ZB, bf16_t* DB, int c, int r0, int t0) {
    float z[31 + W];
#pragma unroll
    for (int m = 0; m < 31 + W; ++m) z[m] = ZB[(r0 + 16 - W + m) * 256 + c];
    float sum = 0.f;
#pragma unroll
    for (int k = 0; k < W - 1; ++k) sum += z[k];
#pragma unroll
    for (int r = 0; r < 32; ++r) {
        const float zt = z[r + W - 1];
        sum += zt;
        const int t = t0 + r0 + r; const int cnt = (t + 1 < W) ? t + 1 : W;
        DB[(r0 + r) * 264 + c] = f2bf(sum * __builtin_amdgcn_rcpf((float)cnt) - zt);
        sum -= z[r];
    }
}
template <int NR>
__device__ __forceinline__ void c_stage(const bf16_t* __restrict__ PR, size_t C0, bf16_t* VT, int wid, int lane, const float* lg, const float* lb) {
    const float g0 = lg[lane], g1 = lg[lane + 64], g2 = lg[lane + 128], g3 = lg[lane + 192], b0 = lb[lane], b1 = lb[lane + 64], b2 = lb[lane + 128], b3 = lb[lane + 192];
#pragma unroll 1
    for (int j8 = 0; j8 < NR; j8 += 8) {
        unsigned short v[8][4];
#pragma unroll
        for (int jj = 0; jj < 8; ++jj) { const bf16_t* p = PR + (C0 + wid + 8 * (j8 + jj)) * INW + 1024 + lane; v[jj][0] = p[0]; v[jj][1] = p[64]; v[jj][2] = p[128]; v[jj][3] = p[192]; }
#pragma unroll
        for (int jj = 0; jj < 8; ++jj) {
            const int j = wid + 8 * (j8 + jj);
            const float v0 = bf2f(v[jj][0]), v1 = bf2f(v[jj][1]), v2 = bf2f(v[jj][2]), v3 = bf2f(v[jj][3]);
            const float mean = wave_sum((v0 + v1) + (v2 + v3)) * (1.f / 256.f);
            const float d0 = v0 - mean, d1 = v1 - mean, d2 = v2 - mean, d3 = v3 - mean;
            const float rstd = rsqrtf(wave_sum((d0 * d0 + d1 * d1) + (d2 * d2 + d3 * d3)) * (1.f / 256.f) + LN_EPS);
            VT[(lane) * 136 + j] = f2bf(d0 * rstd * g0 + b0); VT[(lane + 64) * 136 + j] = f2bf(d1 * rstd * g1 + b1);
            VT[(lane + 128) * 136 + j] = f2bf(d2 * rstd * g2 + b2); VT[(lane + 192) * 136 + j] = f2bf(d3 * rstd * g3 + b3);
        }
    }
}
__device__ __forceinline__ void mix_prompt_item(const Params& P, int l, int b, int rb, unsigned char* lds) {
    const int tid = otid(), wid = tid >> 6, lane = tid & 63, fr = lane & 15, fq = lane >> 4;
    const int t0 = 64 * rb; const size_t R0 = (size_t)b * SEQ + t0;
    const bf16_t* __restrict__ PR = (const bf16_t*)(P.ws + WS_PROJ);
    bf16_t* __restrict__ MX = (bf16_t*)(P.ws + WS_MIX);
    float* __restrict__ out = P.out;
#ifndef NO_SEC_A
    {
        float* ZA = (float*)lds;
        {
            u32x2 av[12], ag[12];
#pragma unroll
            for (int jj = 0; jj < 12; ++jj) { const int i = wid + 8 * jj, t = t0 - 30 + i; av[jj] = (u32x2){0u, 0u}; ag[jj] = (u32x2){0u, 0u};
                if (i < 94 && t >= 0) { const bf16_t* p = PR + ((size_t)b * SEQ + t) * INW + 4 * lane; av[jj] = *(const u32x2*)p; ag[jj] = *(const u32x2*)(p + 256); } }
#pragma unroll
            for (int jj = 0; jj < 12; ++jj) { const int i = wid + 8 * jj;
                if (i < 94) { f32x4 z; z.x = bflo(av[jj].x) * sigmoid_(bflo(ag[jj].x)); z.y = bfhi(av[jj].x) * sigmoid_(bfhi(ag[jj].x)); z.z = bflo(av[jj].y) * sigmoid_(bflo(ag[jj].y)); z.w = bfhi(av[jj].y) * sigmoid_(bfhi(ag[jj].y));
                    *(f32x4*)(ZA + i * 256 + 4 * lane) = z; } }
        }
        __syncthreads();
        if (rb == 31) { float* o = out + O_NAP + ((size_t)(l * NB + b) * 30) * 256; for (int idx = tid; idx < 30 * 256; idx += 512) o[idx] = ZA[64 * 256 + idx]; }
        const int c = tid & 255, half = tid >> 8;
        float w[31], acc[32];
        const float* cw = P.in[I_CAW] + (size_t)l * 31 * 256 + c;
#pragma unroll
        for (int k = 0; k < 31; ++k) w[k] = cw[k * 256];
        const float bias = P.in[I_CAB][l * 256 + c];
#pragma unroll
        for (int r = 0; r < 32; ++r) acc[r] = bias;
        const float* zp = ZA + (32 * half) * 256 + c;
#pragma unroll
        for (int r8 = 0; r8 < 4; ++r8) {
#pragma unroll
            for (int i = 0; i < 38; ++i) { const float z = zp[(8 * r8 + i) * 256];
#pragma unroll
                for (int r = 0; r < 8; ++r) { const int k = i - r; if (k >= 0 && k <= 30) acc[8 * r8 + r] = fmaf(w[k], z, acc[8 * r8 + r]); } }
            __builtin_amdgcn_sched_barrier(0);
        }
        __syncthreads();
        float* Y = (float*)lds;
#pragma unroll
        for (int r = 0; r < 32; ++r) Y[(32 * half + r) * 256 + c] = acc[r];
        __syncthreads();
        const f32x4 g = *(const f32x4*)(P.in[I_LNAG] + l * 256 + 4 * lane), bb = *(const f32x4*)(P.in[I_LNAB] + l * 256 + 4 * lane);
        f32x4 v[8];
#pragma unroll
        for (int jj = 0; jj < 8; ++jj) v[jj] = *(const f32x4*)(Y + (wid + 8 * jj) * 256 + 4 * lane);
#pragma unroll
        for (int jj = 0; jj < 8; ++jj) {
            const float mean = wave_sum(sum4(v[jj])) * (1.f / 256.f); const f32x4 d = v[jj] - mean;
            const float rstd = rsqrtf(wave_sum(dot4(d)) * (1.f / 256.f) + LN_EPS);
            const f32x4 y = d * rstd * g + bb;
            u32x2 o; o.x = pk2(silu_(y.x), silu_(y.y)); o.y = pk2(silu_(y.z), silu_(y.w));
            *(u32x2*)(MX + (R0 + wid + 8 * jj) * D + 4 * lane) = o;
        }
        __syncthreads();
    }
#endif
#ifndef NO_SEC_B
    {
        float* ZB = (float*)lds;
        bf16_t* DB = (bf16_t*)(lds + 80896);
        {
            u32x2 zv[10];
#pragma unroll
            for (int jj = 0; jj < 10; ++jj) { const int i = wid + 8 * jj, t = t0 - 15 + i; zv[jj] = (u32x2){0u, 0u};
                if (i < 79 && t >= 0) zv[jj] = *(const u32x2*)(PR + ((size_t)b * SEQ + t) * INW + 512 + 4 * lane); }
#pragma unroll
            for (int jj = 0; jj < 10; ++jj) { const int i = wid + 8 * jj;
                if (i < 79) { f32x4 z; z.x = bflo(zv[jj].x); z.y = bfhi(zv[jj].x); z.z = bflo(zv[jj].y); z.w = bfhi(zv[jj].y); *(f32x4*)(ZB + i * 256 + 4 * lane) = z; } }
        }
        __syncthreads();
        if (rb == 31) { float* o = out + O_NBP + ((size_t)(l * NB + b) * 15) * 256; for (int idx = tid; idx < 15 * 256; idx += 512) o[idx] = ZB[64 * 256 + idx]; }
        {
            const int c = tid & 255, r0 = 32 * (tid >> 8), gsel = wid & 3;
            if (gsel == 0) pool_d<2>(ZB, DB, c, r0, t0); else if (gsel == 1) pool_d<4>(ZB, DB, c, r0, t0); else if (gsel == 2) pool_d<8>(ZB, DB, c, r0, t0); else pool_d<16>(ZB, DB, c, r0, t0);
        }
        __syncthreads();
        {
            const int g = wid & 3, th = wid >> 2;
            const float* pw = P.in[I_POOLW] + ((size_t)(l * 4 + g) * 64) * 64;
            bf16x8 wf[4][2];
#pragma unroll
            for (int nt = 0; nt < 4; ++nt)
#pragma unroll
                for (int ks = 0; ks < 2; ++ks) { const float* q = pw + (size_t)(32 * ks + 8 * fq) * 64 + 16 * nt + fr;
                    u32x4 t; t.x = pk2(q[0], q[64]); t.y = pk2(q[128], q[192]); t.z = pk2(q[256], q[320]); t.w = pk2(q[384], q[448]);
                    wf[nt][ks] = __builtin_bit_cast(bf16x8, t); }
            f32x4 acc[2][4];
#pragma unroll
            for (int tt = 0; tt < 2; ++tt)
#pragma unroll
                for (int nt = 0; nt < 4; ++nt) acc[tt][nt] = (f32x4){0.f, 0.f, 0.f, 0.f};
#pragma unroll
            for (int tt = 0; tt < 2; ++tt)
#pragma unroll
                for (int ks = 0; ks < 2; ++ks) { const bf16x8 df = *(const bf16x8*)(DB + (32 * th + 16 * tt + fr) * 264 + 64 * g + 32 * ks + 8 * fq);
#pragma unroll
                    for (int nt = 0; nt < 4; ++nt) acc[tt][nt] = __builtin_amdgcn_mfma_f32_16x16x32_bf16(wf[nt][ks], df, acc[tt][nt], 0, 0, 0); }
#pragma unroll
            for (int tt = 0; tt < 2; ++tt)
#pragma unroll
                for (int nt = 0; nt < 4; ++nt) { const f32x4 sc = *(const f32x4*)(P.in[I_POOLS] + l * 256 + 64 * g + 16 * nt + 4 * fq); const f32x4 o = acc[tt][nt] * sc;
                    u32x2 w; w.x = pk2(o.x, o.y); w.y = pk2(o.z, o.w);
                    *(u32x2*)(MX + (R0 + 32 * th + 16 * tt + fr) * D + 256 + 64 * g + 16 * nt + 4 * fq) = w; }
        }
        __syncthreads();
    }
#endif
#ifndef NO_SEC_D
    {
        const int c2 = tid & 127, q = tid >> 7;
        const float* cw = P.in[I_CDW] + (size_t)l * 3 * 256 + 2 * c2;
        const float w0a = cw[0], w0b = cw[1], w1a = cw[256], w1b = cw[257], w2a = cw[512], w2b = cw[513];
        unsigned dcv[18], dhv[18], dbv[16];
#pragma unroll
        for (int k = 0; k < 18; ++k) { const int t = t0 + 16 * q + k - 2; dcv[k] = 0u; dhv[k] = 0u; if (k >= 2) dbv[k - 2] = 0u;
            if (t >= 0) { const bf16_t* p = PR + ((size_t)b * SEQ + t) * INW + 2 * c2; dcv[k] = *(const unsigned*)(p + 1536); dhv[k] = *(const unsigned*)(p + 1792); if (k >= 2) dbv[k - 2] = *(const unsigned*)(p + 1280); } }
        float za[18], zb[18];
#pragma unroll
        for (int k = 0; k < 18; ++k) { za[k] = bflo(dcv[k]) * bflo(dhv[k]); zb[k] = bfhi(dcv[k]) * bfhi(dhv[k]); }
#pragma unroll
        for (int r = 0; r < 16; ++r) {
            const float y0 = bflo(dbv[r]) * (w0a * za[r] + w1a * za[r + 1] + w2a * za[r + 2]), y1 = bfhi(dbv[r]) * (w0b * zb[r] + w1b * zb[r + 1] + w2b * zb[r + 2]);
            *(unsigned*)(MX + (R0 + 16 * q + r) * D + 768 + 2 * c2) = pk2(y0, y1);
        }
        if (rb == 31 && q == 3) { float* o = out + O_NDP + ((size_t)(l * NB + b) * 2) * 256 + 2 * c2; o[0] = za[16]; o[1] = zb[16]; o[256] = za[17]; o[257] = zb[17]; }
    }
#endif
#ifndef NO_SEC_C
    {
        const int n = rb >> 1, hf = rb & 1;
        const size_t C0 = (size_t)b * SEQ + 128 * n;
        bf16_t* VT = (bf16_t*)lds;
        if (hf) c_stage<16>(PR, C0, VT, wid, lane, P.in[I_LNCG] + l * 256, P.in[I_LNCB] + l * 256);
        else c_stage<8>(PR, C0, VT, wid, lane, P.in[I_LNCG] + l * 256, P.in[I_LNCB] + l * 256);
        __syncthreads();
        const int h = wid & 3, I0 = 64 * hf + 32 * (wid >> 2);
        const float* W = P.in[I_SGUW] + ((size_t)(l * 4 + h) * 128) * 128;
        f32x4 acc[2][4];
#pragma unroll
        for (int it = 0; it < 2; ++it)
#pragma unroll
            for (int nt = 0; nt < 4; ++nt) acc[it][nt] = (f32x4){0.f, 0.f, 0.f, 0.f};
        u32x2 cuv[2][4];
#pragma unroll
        for (int it = 0; it < 2; ++it)
#pragma unroll
            for (int nt = 0; nt < 4; ++nt) cuv[it][nt] = *(const u32x2*)(PR + (C0 + I0 + 16 * it + fr) * INW + 768 + 64 * h + 16 * nt + 4 * fq);
#pragma unroll
        for (int it = 0; it < 2; ++it) {
            const int i0 = I0 + 16 * it, i = i0 + fr, nks = (i0 >> 5) + 1;
            for (int ks = 0; ks < nks; ++ks) {
                const int j0 = 32 * ks + 8 * fq;
                f32x4 wa = *(const f32x4*)(W + (size_t)i * 128 + j0), wb = *(const f32x4*)(W + (size_t)i * 128 + j0 + 4);
                wa.x = (j0 + 0 <= i) ? wa.x : 0.f; wa.y = (j0 + 1 <= i) ? wa.y : 0.f; wa.z = (j0 + 2 <= i) ? wa.z : 0.f; wa.w = (j0 + 3 <= i) ? wa.w : 0.f;
                wb.x = (j0 + 4 <= i) ? wb.x : 0.f; wb.y = (j0 + 5 <= i) ? wb.y : 0.f; wb.z = (j0 + 6 <= i) ? wb.z : 0.f; wb.w = (j0 + 7 <= i) ? wb.w : 0.f;
                u32x4 t; t.x = pk2(wa.x, wa.y); t.y = pk2(wa.z, wa.w); t.z = pk2(wb.x, wb.y); t.w = pk2(wb.z, wb.w);
                const bf16x8 wfrag = __builtin_bit_cast(bf16x8, t);
#pragma unroll
                for (int nt = 0; nt < 4; ++nt) { const bf16x8 vf = *(const bf16x8*)(VT + (64 * h + 16 * nt + fr) * 136 + j0);
                    acc[it][nt] = __builtin_amdgcn_mfma_f32_16x16x32_bf16(vf, wfrag, acc[it][nt], 0, 0, 0); }
            }
        }
#pragma unroll
        for (int it = 0; it < 2; ++it) {
            const int i = I0 + 16 * it + fr; const float bs = P.in[I_SGUB][(l * 4 + h) * 128 + i]; const size_t row = C0 + i;
#pragma unroll
            for (int nt = 0; nt < 4; ++nt) { const int cc = 64 * h + 16 * nt + 4 * fq; const u32x2 cu = cuv[it][nt];
                const f32x4 a = acc[it][nt] + bs;
                u32x2 o; o.x = pk2(bflo(cu.x) * a.x, bfhi(cu.x) * a.y); o.y = pk2(bflo(cu.y) * a.z, bfhi(cu.y) * a.w);
                *(u32x2*)(MX + row * D + 512 + cc) = o; }
        }
        __syncthreads();
    }
#endif
}

__device__ __forceinline__ void mix_sample_item(const Params& P, int l, int pair, unsigned char* lds) {
    const int tid = otid(), wid = tid >> 6, lane = tid & 63, c = tid & 255, hs = tid >> 8, s = 2 * pair + hs;
    const bf16_t* __restrict__ PR = (const bf16_t*)(P.ws + WS_PROJ);
    bf16_t* __restrict__ MX = (bf16_t*)(P.ws + WS_MIX);
    float* __restrict__ out = P.out;
    const size_t row = (size_t)MP + s;
    const bf16_t* p = PR + row * INW + c;
    const float av = bf2f(p[0]), ag = bf2f(p[256]), bi = bf2f(p[512]), cu = bf2f(p[768]), cv = bf2f(p[1024]), db = bf2f(p[1280]), dc = bf2f(p[1536]), dh = bf2f(p[1792]);
    const float* __restrict__ sa = P.in[I_SA] + ((size_t)(l * NS + s) * 30) * 256 + c;
    const float* __restrict__ sb = P.in[I_SB] + ((size_t)(l * NS + s) * 15) * 256 + c;
    const float* __restrict__ sd = P.in[I_SD] + ((size_t)(l * NS + s) * 2) * 256 + c;
    const float* __restrict__ caw = P.in[I_CAW] + (size_t)l * 31 * 256 + c;
    float sav[30], sbv[15], cwv[31];
#pragma unroll
    for (int k = 0; k < 30; ++k) sav[k] = sa[k * 256];
#pragma unroll
    for (int k = 0; k < 15; ++k) sbv[k] = sb[k * 256];
#pragma unroll
    for (int k = 0; k < 31; ++k) cwv[k] = caw[k * 256];
    const float s0 = sd[0], s1 = sd[256];
    const float za = av * sigmoid_(ag);
    float* na = out + O_NAS + ((size_t)(l * NS + s) * 30) * 256 + c;
    float ya = P.in[I_CAB][l * 256 + c];
#pragma unroll
    for (int k = 0; k < 30; ++k) { ya = fmaf(cwv[k], sav[k], ya); if (k >= 1) na[(k - 1) * 256] = sav[k]; }
    ya = fmaf(cwv[30], za, ya); na[29 * 256] = za;
    const int g = c >> 6, w = 2 << g;
    float* nb = out + O_NBS + ((size_t)(l * NS + s) * 15) * 256 + c;
    float sum = bi;
#pragma unroll
    for (int k = 0; k < 15; ++k) { if (k >= 16 - w) sum += sbv[k]; if (k >= 1) nb[(k - 1) * 256] = sbv[k]; }
    nb[14 * 256] = bi;
    const float dpool = sum * (1.f / (float)w) - bi;
    const float zd = dc * dh;
    float* nd = out + O_NDS + ((size_t)(l * NS + s) * 2) * 256 + c;
    const float* cdw = P.in[I_CDW] + (size_t)l * 3 * 256 + c;
    const float yd = db * (cdw[0] * s0 + cdw[256] * s1 + cdw[512] * zd);
    nd[0] = s1; nd[256] = zd;
    const float r0 = wave_sum(ya), r1 = wave_sum(cv);
    float* RED = (float*)lds;
    float* DL = RED + 64;
    if (lane == 0) { RED[wid * 4 + 0] = r0; RED[wid * 4 + 1] = r1; }
    DL[hs * 256 + c] = dpool;
    __syncthreads();
    const int wb = hs * 16;
    const float meanA = ((RED[wb + 0] + RED[wb + 4]) + (RED[wb + 8] + RED[wb + 12])) * (1.f / 256.f);
    const float meanC = ((RED[wb + 1] + RED[wb + 5]) + (RED[wb + 9] + RED[wb + 13])) * (1.f / 256.f);
    const float da = ya - meanA, dcv = cv - meanC;
    const float q0 = wave_sum(da * da), q1 = wave_sum(dcv * dcv);
    if (lane == 0) { RED[wid * 4 + 2] = q0; RED[wid * 4 + 3] = q1; }
    __syncthreads();
    const float rstdA = rsqrtf(((RED[wb + 2] + RED[wb + 6]) + (RED[wb + 10] + RED[wb + 14])) * (1.f / 256.f) + LN_EPS);
    const float rstdC = rsqrtf(((RED[wb + 3] + RED[wb + 7]) + (RED[wb + 11] + RED[wb + 15])) * (1.f / 256.f) + LN_EPS);
    const float yA = silu_(da * rstdA * P.in[I_LNAG][l * 256 + c] + P.in[I_LNAB][l * 256 + c]);
    const float vn = dcv * rstdC * P.in[I_LNCG][l * 256 + c] + P.in[I_LNCB][l * 256 + c];
    out[O_NVS + (size_t)(l * NS + s) * 256 + c] = vn;
    const float yc = cu * (P.in[I_SGUW][((size_t)(l * 4 + g) * 128) * 128] * vn + P.in[I_SGUB][(l * 4 + g) * 128]);
    const float* __restrict__ pw = P.in[I_POOLW] + ((size_t)(l * 4 + g) * 64) * 64 + (c & 63);
    float yb = 0.f;
#pragma unroll 16
    for (int cc = 0; cc < 64; ++cc) yb = fmaf(DL[hs * 256 + 64 * g + cc], pw[cc * 64], yb);
    yb *= P.in[I_POOLS][l * 256 + c];
    MX[row * D + c] = f2bf(yA); MX[row * D + 256 + c] = f2bf(yb); MX[row * D + 512 + c] = f2bf(yc); MX[row * D + 768 + c] = f2bf(yd);
    __syncthreads();
}

__global__ void __launch_bounds__(512, 2) mk_fwd(Params P) {
    extern __shared__ __attribute__((aligned(16))) unsigned char lds[];
    const int G = gridDim.x;
#define bx obx()
    unsigned char* ws = P.ws;
    bf16_t* const H = (bf16_t*)(ws + WS_H); bf16_t* const PROJ = (bf16_t*)(ws + WS_PROJ); bf16_t* const MIX = (bf16_t*)(ws + WS_MIX); bf16_t* const GB = (bf16_t*)(ws + WS_G);
    float* const MF = (float*)(ws + WS_MF);
    PG8_LAS unsigned char* ring = (PG8_LAS unsigned char*)lds;
    int ph = 0;
    if (P.pad == 0x7fffffff) cg::this_grid().sync();
    { volatile LAS unsigned* st = (volatile LAS unsigned*)(ring + 131072); if (threadIdx.x < 2) st[threadIdx.x] = 0u; __syncthreads(); }
    XcdBarrier xbar; xbar.bar = (unsigned*)ws; xbar.x = 0; xbar.st = nullptr;
    if (!MK_MULTI) xbar = xcd_barrier_post((unsigned*)ws, (volatile LAS unsigned*)(ring + 131072));
#if MK_MULTI
#define IN_PH() (P.ph_lo <= ph && ph < P.ph_hi)
#else
#define IN_PH() (true)
#endif
#if MK_MULTI
#define SEAM() do { ++ph; } while (0)
#else
#define SEAM() do { for (int rep_ = 0; rep_ < REP_SYNC; ++rep_) xcd_barrier(xbar); ++ph; } while (0)
#endif
    #ifndef NO_P0
    if (IN_PH()) for (int rep = 0; rep < REP_P0; ++rep) p0_prologue(P, lds);
#endif
    SEAM();
    if (IN_PH()) {

#ifndef NO_MOD
        for (int it = bx; it < DEPTH * (NMOD / 16); it += G) { const int l = it / (NMOD / 16), nt = it % (NMOD / 16);
            small_gemm_item<9, 1>(lds, (const bf16_t*)(ws + WS_SC), (const bf16_t*)(ws + WS_WADA) + ((size_t)l * NMOD + 16 * nt) * D, nullptr, D,
                                  (float*)(ws + WS_MOD) + (size_t)l * MODROWS * NMOD, NMOD, 16 * nt, P.in[I_BADA] + (size_t)l * NMOD); }
#endif

    }
    SEAM();
    for (int l = 0; l < DEPTH; ++l) {
        const bf16_t* WIN = (const bf16_t*)(ws + WS_WIN) + (size_t)l * INW * D; const bf16_t* WOUT = (const bf16_t*)(ws + WS_WOUT) + (size_t)l * D * D;
        const bf16_t* WGU = (const bf16_t*)(ws + WS_WGU) + (size_t)l * 2 * FF * D; const bf16_t* WDN = (const bf16_t*)(ws + WS_WDN) + (size_t)l * D * FF;
        if (l == 0) {
#ifndef NO_NORM
 if (IN_PH()) { for (int rep = 1; rep < REP_NORM; ++rep) norm_phase(P, 0, 0, true); norm_phase(P, 0, 0); }
#endif
 SEAM(); }
        if (IN_PH()) {
            pg8::Gemm g{H, WIN, MP, INW, D}; pg8::StaticOrder S; S.init(MP, INW, G, bx); EpiStoreBf16 E{PROJ, INW};
#if !defined(NO_GEMM) && (GEMM_MASK & 1)
            for (int rep = 0; rep < REP_GEMM; ++rep) pg8::gemm_phase<EpiStoreBf16, pg8::StaticOrder, true, true>(ring, g, S, E);
#endif
#ifndef NO_SMALL
            for (int rep = 0; rep < REP_SMALL; ++rep) for (int it = bx; it < INW / 16; it += G) small_gemm_item<8, 0>(lds, H + (size_t)MP * D, WIN + (size_t)16 * it * D, nullptr, D, PROJ + (size_t)MP * INW, INW, 16 * it, nullptr);
#endif
        }
        SEAM();
        if (IN_PH()) {
            for (int rep = 0; rep < REP_MIX; ++rep) for (int it = bx; it < NB * 32 + NS / 2; it += G) {
#ifndef NO_MIXP
 if (it < NB * 32) mix_prompt_item(P, l, it >> 5, it & 31, lds);
#endif
#ifndef NO_MIXS
 if (it >= NB * 32) mix_sample_item(P, l, it - NB * 32, lds);
#endif
 }
        }
        SEAM();
        if (IN_PH()) {
            pg8::Gemm g{MIX, WOUT, MP, D, D}; pg8::StaticOrder S; S.init(MP, D, G, bx); EpiStoreF32 E{MF, D};
#if !defined(NO_GEMM) && (GEMM_MASK & 2)
            for (int rep = 0; rep < REP_GEMM; ++rep) pg8::gemm_phase<EpiStoreF32, pg8::StaticOrder, true, true>(ring, g, S, E);
#endif
#ifndef NO_SMALL
            for (int rep = 0; rep < REP_SMALL; ++rep) for (int it = bx; it < D / 16; it += G) small_gemm_item<8, 1>(lds, MIX + (size_t)MP * D, WOUT + (size_t)16 * it * D, nullptr, D, MF + (size_t)MP * D, D, 16 * it, nullptr);
#endif
        }
        SEAM();
#ifndef NO_NORM
        if (IN_PH()) { for (int rep = 1; rep < REP_NORM; ++rep) norm_phase(P, 1, l, true); norm_phase(P, 1, l); }
#endif
        SEAM();
        if (IN_PH()) {
            pg8::Gemm g{H, WGU, MP, 2 * FF, D}; pg8::StaticOrder S; S.init(MP, 2 * FF, G, bx); EpiSwiGLU E{GB};
#if !defined(NO_GEMM) && (GEMM_MASK & 4)
            for (int rep = 0; rep < REP_GEMM; ++rep) pg8::gemm_phase<EpiSwiGLU, pg8::StaticOrder, true, true>(ring, g, S, E);
#endif
#ifndef NO_SMALL
            for (int rep = 0; rep < REP_SMALL; ++rep) for (int it = (bx + G / 2) % G; it < FF / 16; it += G) { const int ff0 = 16 * it; const bf16_t* b0 = WGU + (size_t)(256 * (ff0 >> 7) + (ff0 & 127)) * D;
                small_gemm_item<8, 2>(lds, H + (size_t)MP * D, b0, b0 + (size_t)128 * D, D, GB + (size_t)MP * FF, FF, ff0, nullptr); }
#endif
        }
        SEAM();
        if (IN_PH()) {
            pg8::Gemm g{GB, WDN, MP, D, FF}; pg8::StaticOrder S; S.init(MP, D, G, bx); EpiStoreF32 E{MF, D};
#if !defined(NO_GEMM) && (GEMM_MASK & 8)
            for (int rep = 0; rep < REP_GEMM; ++rep) pg8::gemm_phase<EpiStoreF32, pg8::StaticOrder, true, true>(ring, g, S, E);
#endif
#ifndef NO_SMALL
            for (int rep = 0; rep < REP_SMALL; ++rep) for (int it = bx; it < D / 16; it += G) small_gemm_item<8, 1>(lds, GB + (size_t)MP * FF, WDN + (size_t)16 * it * FF, nullptr, FF, MF + (size_t)MP * D, D, 16 * it, nullptr);
#endif
        }
        SEAM();
#ifndef NO_NORM
        if (IN_PH()) { for (int rep = 1; rep < REP_NORM; ++rep) norm_phase(P, 2, l, true); norm_phase(P, 2, l); }
#endif
        SEAM();
    }
#undef bx
#undef IN_PH
#undef SEAM
}
constexpr int N_PHASES = 2 + 1 + 7 * DEPTH;
}

#ifndef GEMM_MASK
#define GEMM_MASK 15
#endif
extern "C" void kernel_launch(void* const* d_in, const int* in_sizes, int n_in, void* d_out, int out_size, void* d_ws, size_t ws_size, hipStream_t stream) {
    using namespace mk;
    static int grid = 0;
    if (grid == 0) {
        if (n_in != 29 || (size_t)out_size != O_END || ws_size < WS_END) { fprintf(stderr, "kernel_launch: unexpected shapes: n_in %d out %d ws %zu\n", n_in, out_size, ws_size); grid = -1; return; }
        int dev = 0, cus = 0, per_cu = 0;
        hipGetDevice(&dev); hipDeviceGetAttribute(&cus, hipDeviceAttributeMultiprocessorCount, dev);
        if (hipFuncSetAttribute((const void*)mk_fwd, hipFuncAttributeMaxDynamicSharedMemorySize, LDS_BYTES) != hipSuccess) { fprintf(stderr, "kernel_launch: hipFuncSetAttribute failed\n"); grid = -1; return; }
        if (hipOccupancyMaxActiveBlocksPerMultiprocessor(&per_cu, (const void*)mk_fwd, 512, LDS_BYTES) != hipSuccess || per_cu < 1) { fprintf(stderr, "kernel_launch: occupancy query says %d\n", per_cu); per_cu = 1; }
        (void)hipGetLastError();
        grid = cus * per_cu;
        fprintf(stderr, "kernel_launch: grid %d (cus %d x %d)\n", grid, cus, per_cu);
    }
    if (grid < 0) return;
    if (hipMemsetAsync(d_ws, 0, 65536, stream) != hipSuccess) { fprintf(stderr, "kernel_launch: memset failed\n"); return; }
    Params p{};
    for (int i = 0; i < 29; ++i) p.in[i] = (const float*)d_in[i];
    p.out = (float*)d_out; p.ws = (unsigned char*)d_ws;
#if MK_MULTI
    for (int ph = 0; ph < N_PHASES; ++ph) { p.ph_lo = ph; p.ph_hi = ph + 1; p.coop = 0; hipLaunchKernelGGL(mk_fwd, dim3(grid), dim3(512), LDS_BYTES, stream, p); }
#else
    p.ph_lo = 0; p.ph_hi = N_PHASES; p.coop = 1;
    void* args[] = {&p};
    hipError_t e = hipLaunchCooperativeKernel((void*)mk_fwd, dim3(grid), dim3(512), args, LDS_BYTES, stream);
    if (e != hipSuccess) fprintf(stderr, "kernel_launch: cooperative launch failed: %s (grid %d)\n", hipGetErrorString(e), grid);
#endif
}
```
